# Optimizing an MI355X kernel written in HIP

```python
import jax, jax.numpy as jnp
from jax import lax
import numpy as np

D_MODEL = 1024
BATCH = 8
SEQ = 2048
DEPTH = 2
DEC_BATCH = 128
DEC_SEQ = 8
PAST_LEN = 16384
PAGE_SIZE = 128

N_MIXERS = 2
N_A_LAYERS = (DEPTH + N_MIXERS - 1) // N_MIXERS
N_B_LAYERS = DEPTH // N_MIXERS

N_MEM = 256
X_WIDTH = D_MODEL // 4
X_HEADS = 4
X_HEAD_DIM = X_WIDTH // X_HEADS

GDN_WIDTH = 3 * D_MODEL // 4
GDN_DK = 128
GDN_DV = 128
GDN_HEADS = GDN_WIDTH // GDN_DV
QKV_WIDTH = GDN_HEADS * (2 * GDN_DK + GDN_DV)
GDN_CONV = 4
GDN_CHUNK = 64

SC_WIDTH = 3 * D_MODEL // 4
SC_CONV = 3

BRANCH_WIDTH = GDN_WIDTH + X_WIDTH
COLS_A = QKV_WIDTH + 2 * GDN_HEADS + BRANCH_WIDTH + X_WIDTH
COLS_B = 3 * SC_WIDTH + BRANCH_WIDTH + X_WIDTH
EPS = 1e-6

kernel_name = 'hybrid_gdn_shortconv_memxattn_step'


def _split(t, sizes):
    return jnp.split(t, [int(s) for s in np.cumsum(sizes)[:-1]], axis=-1)


def rmsnorm(x, g):
    xf = x.astype(jnp.float32)
    r = lax.rsqrt(jnp.mean(xf * xf, axis=-1, keepdims=True) + EPS)
    return (xf * r * g.astype(jnp.float32)).astype(x.dtype)


def l2norm(x):
    return x * lax.rsqrt(jnp.sum(x * x, axis=-1, keepdims=True) + EPS)


def causal_dwconv(x, buf, w):
    width = w.shape[0]
    L = x.shape[1]
    xp = jnp.concatenate([buf.astype(x.dtype), x], axis=1)
    y = sum(xp[:, j:j + L] * w[j].astype(x.dtype) for j in range(width))
    return y, xp[:, xp.shape[1] - (width - 1):]


def gated_delta_rule(q, k, v, g, beta, S0):
    Bn, L, H, DK = q.shape
    C = min(GDN_CHUNK, L)
    n = -(-L // C)
    pad = n * C - L

    def blocks(t):
        t = jnp.pad(t, [(0, 0), (0, pad)] + [(0, 0)] * (t.ndim - 2))
        t = t.reshape((Bn, n, C) + t.shape[2:])
        return jnp.moveaxis(t, 3, 2)

    q, k, v, g, beta = (blocks(t) for t in (q, k, v, g, beta))
    G = jnp.cumsum(g, axis=-1)
    tril = jnp.tril(jnp.ones((C, C), bool))
    decay = jnp.exp(jnp.where(tril, G[..., :, None] - G[..., None, :], -jnp.inf))
    kb = k * beta[..., None]
    A = jnp.tril(jnp.einsum('bnhid,bnhjd->bnhij', kb, k) * decay, -1)
    rhs = jnp.concatenate([kb * jnp.exp(G)[..., None], v * beta[..., None]], axis=-1)
    wu = lax.linalg.triangular_solve(A + jnp.eye(C, dtype=A.dtype), rhs, left_side=True,
                                     lower=True, unit_diagonal=True)
    w, u = wu[..., :DK], wu[..., DK:]
    Aqk = jnp.einsum('bnhid,bnhjd->bnhij', q, k) * decay
    qd = q * jnp.exp(G)[..., None]
    Gl = G[..., -1]
    kd = k * jnp.exp(Gl[..., None] - G)[..., None]
    xs = tuple(jnp.moveaxis(t, 1, 0) for t in (w, u, qd, kd, Aqk, Gl))

    def step(S, inp):
        w_c, u_c, qd_c, kd_c, aqk_c, gl_c = inp
        v_new = u_c - jnp.einsum('bhcd,bhde->bhce', w_c, S)
        o_c = (jnp.einsum('bhcd,bhde->bhce', qd_c, S)
               + jnp.einsum('bhij,bhje->bhie', aqk_c, v_new))
        S = S * jnp.exp(gl_c)[..., None, None] + jnp.einsum('bhcd,bhce->bhde', kd_c, v_new)
        return S, o_c

    S, o = lax.scan(step, S0, xs)
    o = jnp.transpose(o, (1, 0, 3, 2, 4)).reshape(Bn, n * C, H, -1)[:, :L]
    return o, S


def mem_attend(xq, mk, mv):
    s = jnp.einsum('blhd,bmhd->bhlm', xq, mk.astype(xq.dtype)).astype(jnp.float32)
    p = jax.nn.softmax(s * (X_HEAD_DIM ** -0.5), axis=-1).astype(xq.dtype)
    return jnp.einsum('bhlm,bmhd->blhd', p, mv.astype(xq.dtype))


def gdn_branch(h, w_in, conv_w, a_log, dt_bias, o_norm_g, S0, conv0):
    Bn, L, _ = h.shape
    proj = h @ w_in.astype(h.dtype)
    qkv, b, a, gate, xq = _split(proj, [QKV_WIDTH, GDN_HEADS, GDN_HEADS, BRANCH_WIDTH, X_WIDTH])
    qkv, conv_new = causal_dwconv(qkv, conv0, conv_w)
    qkv = jax.nn.silu(qkv).astype(jnp.float32)
    q, k, v = _split(qkv, [GDN_HEADS * GDN_DK, GDN_HEADS * GDN_DK, GDN_HEADS * GDN_DV])
    q = l2norm(q.reshape(Bn, L, GDN_HEADS, GDN_DK)) * (GDN_DK ** -0.5)
    k = l2norm(k.reshape(Bn, L, GDN_HEADS, GDN_DK))
    v = v.reshape(Bn, L, GDN_HEADS, GDN_DV)
    beta = jax.nn.sigmoid(b.astype(jnp.float32))
    g = -jnp.exp(a_log.astype(jnp.float32)) * jax.nn.softplus(
        a.astype(jnp.float32) + dt_bias.astype(jnp.float32))
    o, S = gated_delta_rule(q, k, v, g, beta, S0.astype(jnp.float32))
    o = rmsnorm(o, o_norm_g).reshape(Bn, L, GDN_WIDTH).astype(h.dtype)
    return o, gate, xq, S, conv_new


def sconv_branch(h, w_in, conv_w, conv0):
    proj = h @ w_in.astype(h.dtype)
    bg, cg, xs, gate, xq = _split(proj, [SC_WIDTH, SC_WIDTH, SC_WIDTH, BRANCH_WIDTH, X_WIDTH])
    y, conv_new = causal_dwconv(cg * xs, conv0, conv_w)
    return bg * y, gate, xq, conv_new


def trunk(x, mem_k, mem_v, gdn_S, gdn_conv, sc_conv, norm_g, w_in_a, conv_w_a, a_log,
          dt_bias, o_norm_g, w_in_b, conv_w_b, w_out, final_norm_g):
    Bn, L, _ = x.shape
    S_new, gconv_new, sconv_new = [], [], []
    for i in range(DEPTH):
        h = rmsnorm(x, norm_g[i])
        j = i // N_MIXERS
        if i % N_MIXERS == 0:
            tok, gate, xq, S, cbuf = gdn_branch(h, w_in_a[j], conv_w_a[j], a_log[j], dt_bias[j],
                                               o_norm_g[j], gdn_S[j], gdn_conv[j])
            S_new.append(S)
            gconv_new.append(cbuf)
        else:
            tok, gate, xq, cbuf = sconv_branch(h, w_in_b[j], conv_w_b[j], sc_conv[j])
            sconv_new.append(cbuf)
        xo = mem_attend(xq.reshape(Bn, L, X_HEADS, X_HEAD_DIM), mem_k[i], mem_v[i])
        br = jnp.concatenate([tok, xo.reshape(Bn, L, X_WIDTH)], axis=-1) * jax.nn.silu(gate)
        x = x + br @ w_out[i].astype(x.dtype)
    y = rmsnorm(x, final_norm_g)
    return y, jnp.stack(S_new), jnp.stack(gconv_new), jnp.stack(sconv_new)


def setup_inputs(seed: int = 0) -> dict:
    key = jax.random.key(seed)
    ks = jax.random.split(key, 24)

    def nrm(k, shape, scale):
        return jax.random.normal(k, shape, jnp.float32) * scale

    dt = jnp.exp(jax.random.uniform(ks[11], (N_A_LAYERS, GDN_HEADS), jnp.float32,
                                    np.log(1e-3), np.log(1e-1)))
    return {
        'x_prompt': nrm(ks[0], (BATCH, SEQ, D_MODEL), 1.0),
        'x_sample': nrm(ks[1], (DEC_BATCH, DEC_SEQ, D_MODEL), 1.0),
        'mem_prompt': nrm(ks[2], (BATCH, N_MEM, D_MODEL), 1.0),
        'state_gdn': nrm(ks[3], (N_A_LAYERS, DEC_BATCH, GDN_HEADS, GDN_DK, GDN_DV), 0.05),
        'state_gdn_conv': nrm(ks[4], (N_A_LAYERS, DEC_BATCH, GDN_CONV - 1, QKV_WIDTH), 1.0),
        'state_sconv': nrm(ks[5], (N_B_LAYERS, DEC_BATCH, SC_CONV - 1, SC_WIDTH), 1.0),
        'cache_mem_k': nrm(ks[6], (DEPTH, DEC_BATCH, N_MEM, X_HEADS, X_HEAD_DIM), 1.0),
        'cache_mem_v': nrm(ks[7], (DEPTH, DEC_BATCH, N_MEM, X_HEADS, X_HEAD_DIM), 1.0),
        'norm_g': 1.0 + nrm(ks[8], (DEPTH, D_MODEL), 0.02),
        'w_in_a': nrm(ks[9], (N_A_LAYERS, D_MODEL, COLS_A), D_MODEL ** -0.5),
        'conv_w_a': nrm(ks[10], (N_A_LAYERS, GDN_CONV, QKV_WIDTH), GDN_CONV ** -0.5),
        'a_log': jnp.log(jax.random.uniform(ks[12], (N_A_LAYERS, GDN_HEADS), jnp.float32, 1.0, 16.0)),
        'dt_bias': dt + jnp.log(-jnp.expm1(-dt)),
        'o_norm_g': 1.0 + nrm(ks[13], (N_A_LAYERS, GDN_DV), 0.02),
        'w_in_b': nrm(ks[14], (N_B_LAYERS, D_MODEL, COLS_B), D_MODEL ** -0.5),
        'conv_w_b': nrm(ks[15], (N_B_LAYERS, SC_CONV, SC_WIDTH), SC_CONV ** -0.5),
        'mem_norm_g': 1.0 + nrm(ks[16], (D_MODEL,), 0.02),
        'w_mem_kv': nrm(ks[17], (DEPTH, D_MODEL, 2 * X_WIDTH), D_MODEL ** -0.5),
        'w_out': nrm(ks[18], (DEPTH, BRANCH_WIDTH, D_MODEL), BRANCH_WIDTH ** -0.5),
        'final_norm_g': 1.0 + nrm(ks[19], (D_MODEL,), 0.02),
    }


def reference(x_prompt, x_sample, mem_prompt, state_gdn, state_gdn_conv, state_sconv,
              cache_mem_k, cache_mem_v, norm_g, w_in_a, conv_w_a, a_log, dt_bias, o_norm_g,
              w_in_b, conv_w_b, mem_norm_g, w_mem_kv, w_out, final_norm_g):
    Bp = x_prompt.shape[0]
    n_mem = mem_prompt.shape[1]
    mem_n = rmsnorm(mem_prompt, mem_norm_g)
    mkv = jnp.einsum('bmd,lde->lbme', mem_n, w_mem_kv.astype(mem_n.dtype))
    mem_k_p = mkv[..., :X_WIDTH].reshape(DEPTH, Bp, n_mem, X_HEADS, X_HEAD_DIM)
    mem_v_p = mkv[..., X_WIDTH:].reshape(DEPTH, Bp, n_mem, X_HEADS, X_HEAD_DIM)
    S0_p = jnp.zeros((N_A_LAYERS, Bp, GDN_HEADS, GDN_DK, GDN_DV), jnp.float32)
    gc0_p = jnp.zeros((N_A_LAYERS, Bp, GDN_CONV - 1, QKV_WIDTH), x_prompt.dtype)
    sc0_p = jnp.zeros((N_B_LAYERS, Bp, SC_CONV - 1, SC_WIDTH), x_prompt.dtype)
    y_prompt, S_p, gc_p, sc_p = trunk(x_prompt, mem_k_p, mem_v_p, S0_p, gc0_p, sc0_p,
                                      norm_g, w_in_a, conv_w_a, a_log, dt_bias, o_norm_g,
                                      w_in_b, conv_w_b, w_out, final_norm_g)
    y_sample, S_s, gc_s, sc_s = trunk(x_sample, cache_mem_k, cache_mem_v, state_gdn,
                                      state_gdn_conv, state_sconv,
                                      norm_g, w_in_a, conv_w_a, a_log, dt_bias, o_norm_g,
                                      w_in_b, conv_w_b, w_out, final_norm_g)
    return (y_prompt, y_sample, S_p, gc_p, sc_p, mem_k_p, mem_v_p, S_s, gc_s, sc_s)
```

```cpp
#include <hip/hip_runtime.h>
#include <hip/hip_cooperative_groups.h>
#include <cstdio>
namespace cg = cooperative_groups;

#ifndef MULTI
#define MULTI 0
#endif
#ifndef RUNPH
#define RUNPH 10
#endif

typedef unsigned short bf16_t;
typedef short bf16x8 __attribute__((ext_vector_type(8)));
typedef float f32x4 __attribute__((ext_vector_type(4)));
typedef unsigned u32x4 __attribute__((ext_vector_type(4)));
typedef unsigned u32x2 __attribute__((ext_vector_type(2)));
typedef float f32x2 __attribute__((ext_vector_type(2)));
#define DEV __device__ __forceinline__
DEV int tidx() { int t = threadIdx.x; asm volatile("" : "+v"(t)); return t; }

constexpr int NTOK_P = 16384, NTOK = 17408, NROWS_ALL = 19456;
constexpr int PROJ_LD = 3584, NPA = 3712;
constexpr int C_GATE = 2304, C_XQ = 3328;
constexpr int LDS_BYTES = 73728;
constexpr int NPHASE = 10;

constexpr size_t WS_WTA = 0;
constexpr size_t WS_WTB = WS_WTA + 3712ull * 1024 * 2;
constexpr size_t WS_WTO = WS_WTB + 3584ull * 1024 * 2;
constexpr size_t WS_WTM = WS_WTO + 2ull * 1024 * 1024 * 2;
constexpr size_t WS_XB = WS_WTM + 1024ull * 1024 * 2;
constexpr size_t WS_BR = WS_XB + 17408ull * 1024 * 2;
constexpr size_t WS_MEMB = WS_BR + 17408ull * 1024 * 2;
constexpr size_t WS_RSQ = WS_MEMB + 2048ull * 1024 * 2;
constexpr size_t WS_RSQM = WS_RSQ + 17408ull * 4;
constexpr size_t WS_PART = WS_RSQM + 2048ull * 4;
constexpr size_t WS_BETA = WS_PART + 17408ull * 16 * 4;
constexpr size_t WS_G = WS_BETA + 17408ull * 6 * 4;
constexpr size_t WS_KB = WS_G + 17408ull * 6 * 4;
constexpr size_t WS_VB = WS_KB + 2ull * 2048 * 256 * 2;
constexpr size_t WS_CNT = WS_VB + 2ull * 2048 * 256 * 2;
constexpr size_t WS_BAR = WS_CNT + 256;
constexpr size_t WS_XBAR = WS_BAR + 256;
constexpr size_t WS_EGLP = WS_XBAR + 16384;
constexpr size_t WS_EGLS = WS_EGLP + 1536 * 4;
constexpr size_t WS_PROJ = WS_EGLS + 768 * 4;
constexpr size_t WS_QDP = WS_PROJ + 17408ull * 3584 * 2;
constexpr size_t WS_KDTP = WS_QDP + 1536ull * 16384;
constexpr size_t WS_AQKP = WS_KDTP + 1536ull * 16384;
constexpr size_t WS_END = WS_AQKP + 1536ull * 8192;
constexpr size_t Y_WP = 0;
constexpr size_t Y_UTP = Y_WP + 1536ull * 16384;
constexpr size_t Y_WS = Y_UTP + 1536ull * 16384;
constexpr size_t Y_UTS = Y_WS + 768ull * 4096;
constexpr size_t Y_QDS = Y_UTS + 768ull * 4096;
constexpr size_t Y_KDTS = Y_QDS + 768ull * 4096;
constexpr size_t Y_AQKS = Y_KDTS + 768ull * 8192;
constexpr size_t O_Y = 0, O_SP = 17825792, O_GCP = 18612224, O_SCP = 18667520, O_MK = 18679808, O_MV = 19728384,
                 O_SS = 20776960, O_GCS = 33359872, O_SCS = 34244608;

struct Params {
    const float* in[20];
    float* out;
    unsigned char* ws;
};
enum { I_XP = 0, I_XS, I_MEM, I_SG, I_SGC, I_SSC, I_CK, I_CV, I_NG, I_WA, I_CWA, I_ALOG, I_DTB, I_ONG, I_WB, I_CWB, I_MNG, I_WM, I_WO, I_FNG };

typedef __bf16 bf16v2 __attribute__((ext_vector_type(2)));
DEV unsigned pack2(float lo, float hi) { const f32x2 v = {lo, hi}; return __builtin_bit_cast(unsigned, __builtin_convertvector(v, bf16v2)); }
DEV bf16_t f2bf(float f) { return (bf16_t)(pack2(f, 0.f) & 0xffffu); }
DEV float bf2f(bf16_t h) { return __uint_as_float(((unsigned)h) << 16); }
DEV float bflo(unsigned u) { return __uint_as_float(u << 16); }
DEV float bfhi(unsigned u) { return __uint_as_float(u & 0xffff0000u); }
DEV uint2 pack4(f32x4 v) { return make_uint2(pack2(v[0], v[1]), pack2(v[2], v[3])); }
DEV float silu_f(float x) { return x * __builtin_amdgcn_rcpf(1.f + __expf(-x)); }
DEV float wave_sum(float v) {
#pragma unroll
    for (int o = 32; o > 0; o >>= 1) v += __shfl_xor(v, o);
    return v;
}
DEV f32x4 mfma16(bf16x8 a, bf16x8 b, f32x4 c) { return __builtin_amdgcn_mfma_f32_16x16x32_bf16(a, b, c, 0, 0, 0); }
DEV bf16x8 ld8(const bf16_t* p) { return *reinterpret_cast<const bf16x8*>(p); }

#define XB_TMO      128
#define XB_XCNT(j)  (256  + 64 * (j))
#define XB_XSUB(j)  (1280 + 64 * (j))
#define XB_XGEN(j)  (2304 + 64 * (j))
#define XB_TOP      3328
#define XB_TOPGEN   3392
#define XCD_BAR_WORDS 3456
#define XB_SPIN_CAP (1u << 18)
#define LAS __attribute__((address_space(3)))

__device__ __forceinline__ unsigned xb_ld(unsigned* p)              { return __hip_atomic_load(p, __ATOMIC_RELAXED, __HIP_MEMORY_SCOPE_AGENT); }
__device__ __forceinline__ unsigned xb_add(unsigned* p, unsigned v) { return __hip_atomic_fetch_add(p, v, __ATOMIC_RELAXED, __HIP_MEMORY_SCOPE_AGENT); }
__device__ __forceinline__ unsigned xb_xcc_id() { return (unsigned)__builtin_amdgcn_s_getreg((3 << 11) | 20) & 0xFu; }
#define XB_SPIN(cond, bar) do { unsigned _sp = 0; while (cond) { __builtin_amdgcn_s_sleep(1); \
    if ((++_sp & 255u) == 0u) { if (xb_ld(&(bar)[XB_TMO])) break; if (_sp > XB_SPIN_CAP) { atomicAdd(&(bar)[XB_TMO], 1u); break; } } } } while (0)

struct XcdBarrier {
    unsigned* bar; unsigned x;
    volatile LAS unsigned* st;
};

__device__ __forceinline__ XcdBarrier xcd_barrier_post(unsigned* bar, volatile LAS unsigned* st) {
    XcdBarrier b; b.bar = bar; b.x = xb_xcc_id(); b.st = st;
    if (threadIdx.x == 0) (void)xb_add(&bar[XB_XCNT(b.x)], 1u);
    return b;
}
__device__ __forceinline__ void xcd_barrier_complete(unsigned* bar, unsigned x, unsigned& nloc, unsigned& nx) {
    const unsigned G = gridDim.x * gridDim.y * gridDim.z;
    unsigned sum, cnt, mine, sp = 0u;
    for (;;) {
        sum = 0u; cnt = 0u; mine = 0u;
#pragma unroll
        for (unsigned j = 0; j < 16; ++j) { const unsigned c = xb_ld(&bar[XB_XCNT(j)]); sum += c; cnt += (c > 0u) ? 1u : 0u; mine = (j == x) ? c : mine; }
        if (sum == G) break;
        __builtin_amdgcn_s_sleep(1);
        if ((++sp & 255u) == 0u) { if (xb_ld(&bar[XB_TMO])) break; if (sp > XB_SPIN_CAP) { atomicAdd(&bar[XB_TMO], 1u); break; } }
    }
    nloc = mine > 0u ? mine : 1u; nx = cnt > 0u ? cnt : 1u;
}

__device__ __forceinline__ void xcd_barrier(const XcdBarrier& b) {
    asm volatile("s_waitcnt vmcnt(0)" ::: "memory");
    __syncthreads();
    if (threadIdx.x == 0) {
        unsigned* bar = b.bar;
        __builtin_amdgcn_s_waitcnt(0);
        unsigned nloc = b.st[0], nx = b.st[1];
        if (nloc == 0u) { xcd_barrier_complete(bar, b.x, nloc, nx); b.st[0] = nloc; b.st[1] = nx; }
        const unsigned old = xb_add(&bar[XB_XSUB(b.x)], 1u);
        const unsigned gen = old / nloc;
        if (old + 1u == (gen + 1u) * nloc) {
            __builtin_amdgcn_fence(__ATOMIC_RELEASE, "agent");
            asm volatile("s_waitcnt vmcnt(0)" ::: "memory");
            const unsigned og = xb_add(&bar[XB_TOP], 1u);
            const unsigned tg = og / nx;
            if (og + 1u == (tg + 1u) * nx) xb_add(&bar[XB_TOPGEN], 1u);
            else XB_SPIN(xb_ld(&bar[XB_TOPGEN]) == tg, bar);
            __builtin_amdgcn_fence(__ATOMIC_ACQUIRE, "agent");
            xb_add(&bar[XB_XGEN(b.x)], 1u);
            asm volatile("s_waitcnt vmcnt(0)" ::: "memory");
        } else {
            XB_SPIN(xb_ld(&bar[XB_XGEN(b.x)]) == gen, bar);
            __builtin_amdgcn_fence(__ATOMIC_ACQUIRE, "agent");
            asm volatile("s_waitcnt vmcnt(0)" ::: "memory");
        }
    }
    __syncthreads();
}


DEV void grid_barrier(unsigned* bar, unsigned target) {
    asm volatile("s_waitcnt vmcnt(0) lgkmcnt(0)" ::: "memory");
    __syncthreads();
    if (threadIdx.x == 0) {
        __builtin_amdgcn_fence(__ATOMIC_RELEASE, "agent");
        asm volatile("s_waitcnt vmcnt(0)" ::: "memory");
        __hip_atomic_fetch_add(bar, 1u, __ATOMIC_RELAXED, __HIP_MEMORY_SCOPE_AGENT);
        while (__hip_atomic_load(bar, __ATOMIC_RELAXED, __HIP_MEMORY_SCOPE_AGENT) < target) __builtin_amdgcn_s_sleep(2);
        __builtin_amdgcn_fence(__ATOMIC_ACQUIRE, "agent");
        asm volatile("s_waitcnt vmcnt(0)" ::: "memory");
    }
    __syncthreads();
}

DEV int next_item(unsigned* cnt, int* sh) {
    __syncthreads();
    if (threadIdx.x == 0) *sh = (int)atomicAdd(cnt, 1u);
    __syncthreads();
    return *sh;
}

DEV void prep_wtile(const float* __restrict__ src, int ld, const float* __restrict__ g, bf16_t* __restrict__ dst, int n0, int k0, int mode, unsigned char* smem) {
    float* tile = (float*)smem;
    const int tid = tidx();
    {
        const int n = tid & 63;
        int nn = n0 + n, col = nn;
        if (mode == 1) { col = nn < 2304 ? nn : (nn < 3584 ? nn + 12 : (nn < 3596 ? nn - 1280 : -1)); }
        float v[16];
#pragma unroll
        for (int i = 0; i < 16; ++i) {
            const int k = i * 4 + (tid >> 6);
            v[i] = (col >= 0) ? src[(size_t)(k0 + k) * ld + col] : 0.f;
        }
#pragma unroll
        for (int i = 0; i < 16; ++i) {
            const int k = i * 4 + (tid >> 6);
            tile[k * 65 + n] = g ? v[i] * g[k0 + k] : v[i];
        }
    }
    __syncthreads();
    {
        const int n = tid >> 2, ks = tid & 3;
        unsigned w[8];
#pragma unroll
        for (int i = 0; i < 8; ++i) w[i] = pack2(tile[(ks * 16 + 2 * i) * 65 + n], tile[(ks * 16 + 2 * i + 1) * 65 + n]);
        uint4* d = (uint4*)(dst + (size_t)(n0 + n) * 1024 + k0 + ks * 16);
        d[0] = make_uint4(w[0], w[1], w[2], w[3]);
        d[1] = make_uint4(w[4], w[5], w[6], w[7]);
    }
    __syncthreads();
}

DEV void phase_prep(const Params& p, unsigned char* smem) {
    const int tid = tidx(), lane = tid & 63, wid = tid >> 6;
    if (blockIdx.x == 0 && tid < 64) ((unsigned*)(p.ws + WS_CNT))[tid] = 0u;
    bf16_t* WtA = (bf16_t*)(p.ws + WS_WTA); bf16_t* WtB = (bf16_t*)(p.ws + WS_WTB);
    bf16_t* WtO = (bf16_t*)(p.ws + WS_WTO); bf16_t* WtM = (bf16_t*)(p.ws + WS_WTM);
    const int NW = 928 + 256, NR = NROWS_ALL / 4;
    for (int it = blockIdx.x; it < NW + NR; it += gridDim.x) {
        if (it < NW) {
            int t = it;
            if (t < 928) { prep_wtile(p.in[I_WA], 3596, p.in[I_NG], WtA, (t >> 4) * 64, (t & 15) * 64, 1, smem); }
            else { t -= 928; int l = t >> 7, tt = t & 127; prep_wtile(p.in[I_WM] + (size_t)l * 1024 * 512, 512, p.in[I_MNG], WtM + (size_t)l * 512 * 1024, (tt >> 4) * 64, (tt & 15) * 64, 0, smem); }
        } else {
            const int row = (it - NW) * 4 + wid;
            const float* src; bf16_t* dst; float* rs;
            if (row < NTOK_P) { src = p.in[I_XP] + (size_t)row * 1024; dst = (bf16_t*)(p.ws + WS_XB) + (size_t)row * 1024; rs = (float*)(p.ws + WS_RSQ) + row; }
            else if (row < NTOK) { src = p.in[I_XS] + (size_t)(row - NTOK_P) * 1024; dst = (bf16_t*)(p.ws + WS_XB) + (size_t)row * 1024; rs = (float*)(p.ws + WS_RSQ) + row; }
            else { src = p.in[I_MEM] + (size_t)(row - NTOK) * 1024; dst = (bf16_t*)(p.ws + WS_MEMB) + (size_t)(row - NTOK) * 1024; rs = (float*)(p.ws + WS_RSQM) + (row - NTOK); }
            float4 v[4]; float ss = 0.f;
#pragma unroll
            for (int i = 0; i < 4; ++i) { v[i] = ((const float4*)src)[i * 64 + lane]; ss += v[i].x * v[i].x + v[i].y * v[i].y + v[i].z * v[i].z + v[i].w * v[i].w; }
            ss = wave_sum(ss);
            if (lane == 0) *rs = rsqrtf(ss * (1.f / 1024.f) + 1e-6f);
#pragma unroll
            for (int i = 0; i < 4; ++i) ((uint2*)dst)[i * 64 + lane] = make_uint2(pack2(v[i].x, v[i].y), pack2(v[i].z, v[i].w));
        }
    }
}

template <int MF = 4, bool STAGED = false, class Epi>
DEV void gemm_tile(const bf16_t* __restrict__ A, const bf16_t* __restrict__ Bt, int m0, int n0, unsigned char* smem, const Epi& epi) {
    const int tid = tidx(), lane = tid & 63, wid = tid >> 6, wr = wid >> 1, wc = wid & 1;
    const int fr = lane & 15, fq = lane >> 4;
    bf16_t* As = (bf16_t*)smem;
    bf16_t* Bs = As + 2 * 128 * 64;
    f32x4 acc[MF][4];
#pragma unroll
    for (int m = 0; m < MF; ++m)
#pragma unroll
        for (int n = 0; n < 4; ++n) acc[m][n] = (f32x4){0.f, 0.f, 0.f, 0.f};
    const int lrow = tid >> 3, lseg = tid & 7;
    const bf16_t* Ag = A + (size_t)(m0 + lrow) * 1024 + lseg * 8;
    const bf16_t* Bg = Bt + (size_t)(n0 + lrow) * 1024 + lseg * 8;
    typedef __attribute__((address_space(3))) void* lds_ptr_t;
    const int gch = (lseg ^ (lrow & 7)) * 8;
    auto stage = [&](int kt, int buf) {
        bf16_t* An = As + buf * 128 * 64; bf16_t* Bn = Bs + buf * 128 * 64;
#pragma unroll
        for (int i = 0; i < 4; ++i) {
            if (i < MF) __builtin_amdgcn_global_load_lds((const unsigned*)(Ag - lseg * 8 + gch + (size_t)i * 32 * 1024 + kt * 64), (lds_ptr_t)(An + (lrow + i * 32) * 64 + lseg * 8), 16, 0, 0);
            __builtin_amdgcn_global_load_lds((const unsigned*)(Bg - lseg * 8 + gch + (size_t)i * 32 * 1024 + kt * 64), (lds_ptr_t)(Bn + (lrow + i * 32) * 64 + lseg * 8), 16, 0, 0);
        }
    };
    auto compute = [&](int buf) {
        const bf16_t* Ac = As + buf * 128 * 64 + (wr * (MF * 16) + fr) * 64;
        const bf16_t* Bc = Bs + buf * 128 * 64 + (wc * 64 + fr) * 64;
#pragma unroll
        for (int ks = 0; ks < 2; ++ks) {
            bf16x8 af[MF], bfv[4];
            const int co = ((ks * 4 + fq) ^ (fr & 7)) * 8;
#pragma unroll
            for (int m = 0; m < MF; ++m) af[m] = ld8(Ac + m * 16 * 64 + co);
#pragma unroll
            for (int n = 0; n < 4; ++n) bfv[n] = ld8(Bc + n * 16 * 64 + co);
#pragma unroll
            for (int m = 0; m < MF; ++m)
#pragma unroll
                for (int n = 0; n < 4; ++n) acc[m][n] = mfma16(bfv[n], af[m], acc[m][n]);
        }
    };
    __syncthreads();
    stage(0, 0);
#pragma unroll 1
    for (int kt = 0; kt < 16; ++kt) {
        const int cur = kt & 1;
        asm volatile("s_waitcnt vmcnt(0)" ::: "memory");
        __syncthreads();
        if (kt + 1 < 16) stage(kt + 1, cur ^ 1);
        compute(cur);
    }
    if constexpr (STAGED) {
        bf16_t* Cs = (bf16_t*)smem;
        __syncthreads();
#pragma unroll
        for (int m = 0; m < MF; ++m) {
            const int rl = wr * (MF * 16) + m * 16 + fr;
            const float sc = epi.scale(m0 + rl);
#pragma unroll
            for (int n = 0; n < 4; ++n) {
                const f32x4 v = acc[m][n] * sc;
                epi.special(m0 + rl, n0 + wc * 64 + n * 16 + fq * 4, v);
                *(uint2*)(Cs + rl * 136 + wc * 64 + n * 16 + fq * 4) = pack4(v);
            }
        }
        __syncthreads();
#pragma unroll
        for (int i = 0; i < MF * 2; ++i) {
            const int idx = i * 256 + tid, rl = idx >> 4, ch = idx & 15;
            epi.store(m0 + rl, n0 + ch * 8, *(const u32x4*)(Cs + rl * 136 + ch * 8));
        }
    } else {
#pragma unroll
        for (int m = 0; m < MF; ++m) epi(m0 + wr * (MF * 16) + m * 16 + fr, n0 + wc * 64 + fq * 4, acc[m]);
    }
}

struct EpiA {
    const float* rsq; bf16_t* proj; float* beta; float* gbuf; const float* a_log; const float* dt_bias; float* gcp; float* gcs;
    DEV void operator()(int row, int col0, const f32x4 (&acc)[4]) const {
        const float r = rsq[row];
#pragma unroll
        for (int n = 0; n < 4; ++n) {
            const int col = col0 + n * 16;
            f32x4 v = acc[n] * r;
            if (col < PROJ_LD) {
                *(uint2*)(proj + (size_t)row * PROJ_LD + col) = pack4(v);
                if (col < 2304) {
                    if (row < NTOK_P) { const int t = row & 2047; if (t >= 2045) *(f32x4*)(gcp + (size_t)((row >> 11) * 3 + (t - 2045)) * 2304 + col) = v; }
                    else { const int rs = row - NTOK_P, t = rs & 7; if (t >= 5) *(f32x4*)(gcs + (size_t)((rs >> 3) * 3 + (t - 5)) * 2304 + col) = v; }
                }
            } else {
#pragma unroll
                for (int j = 0; j < 4; ++j) {
                    const int cc = col - PROJ_LD + j;
                    if (cc < 6) beta[row * 6 + cc] = 1.f / (1.f + expf(-v[j]));
                    else if (cc < 12) { const int h = cc - 6; const float z = v[j] + dt_bias[h]; const float sp = z > 20.f ? z : log1pf(expf(z)); gbuf[row * 6 + h] = -expf(a_log[h]) * sp; }
                }
            }
        }
    }
};
struct EpiA2 {
    const float* rsq; bf16_t* proj; float* gcp; float* gcs;
    DEV float scale(int row) const { return rsq[row]; }
    DEV void special(int row, int col, f32x4 v) const {
        if (col < 2304) {
            if (row < NTOK_P) { const int t = row & 2047; if (t >= 2045) *(f32x4*)(gcp + (size_t)((row >> 11) * 3 + (t - 2045)) * 2304 + col) = v; }
            else { const int rs = row - NTOK_P, t = rs & 7; if (t >= 5) *(f32x4*)(gcs + (size_t)((rs >> 3) * 3 + (t - 5)) * 2304 + col) = v; }
        }
    }
    DEV void store(int row, int col, u32x4 c) const { *(u32x4*)(proj + (size_t)row * PROJ_LD + col) = c; }
};
struct EpiB2 {
    const float* part; bf16_t* proj;
    DEV float scale(int row) const {
        float ss = 0.f;
#pragma unroll
        for (int i = 0; i < 4; ++i) { const f32x4 q = *(const f32x4*)(part + row * 16 + i * 4); ss += q[0] + q[1] + q[2] + q[3]; }
        return rsqrtf(ss * (1.f / 1024.f) + 1e-6f);
    }
    DEV void special(int, int, f32x4) const {}
    DEV void store(int row, int col, u32x4 c) const { *(u32x4*)(proj + (size_t)row * PROJ_LD + col) = c; }
};
struct EpiM {
    const float* rsq; float* mk; float* mv; bf16_t* kb; bf16_t* vb;
    DEV void operator()(int row, int col0, const f32x4 (&acc)[4]) const {
        const float r = rsq[row];
#pragma unroll
        for (int n = 0; n < 4; ++n) {
            const int col = col0 + n * 16, l = col >> 9, e = col & 511, e2 = e & 255;
            f32x4 v = acc[n] * r;
            const size_t idx = ((size_t)l * 2048 + row) * 256 + e2;
            if (e < 256) { *(f32x4*)(mk + idx) = v; *(uint2*)(kb + idx) = pack4(v); }
            else { *(f32x4*)(mv + idx) = v; *(uint2*)(vb + idx) = pack4(v); }
        }
    }
};
struct EpiO {
    const float* xp; const float* xs; bf16_t* xb; float* part; int n0;
    DEV void operator()(int row, int col0, const f32x4 (&acc)[4]) const {
        float ss = 0.f;
#pragma unroll
        for (int n = 0; n < 4; ++n) {
            const int col = col0 + n * 16;
            f32x4 v;
            if (xp) {
                const float* xr = row < NTOK_P ? xp + (size_t)row * 1024 : xs + (size_t)(row - NTOK_P) * 1024;
                v = acc[n] + *(const f32x4*)(xr + col);
            } else {
                const uint2 u = *(const uint2*)(xb + (size_t)row * 1024 + col);
                v[0] = acc[n][0] + bflo(u.x); v[1] = acc[n][1] + bfhi(u.x); v[2] = acc[n][2] + bflo(u.y); v[3] = acc[n][3] + bfhi(u.y);
            }
            *(uint2*)(xb + (size_t)row * 1024 + col) = pack4(v);
            ss += v[0] * v[0] + v[1] * v[1] + v[2] * v[2] + v[3] * v[3];
        }
        ss += __shfl_xor(ss, 16); ss += __shfl_xor(ss, 32);
        if ((threadIdx.x & 63) < 16) part[row * 16 + (n0 >> 7) * 2 + ((threadIdx.x >> 6) & 1)] = ss;
    }
};
struct EpiB {
    const float* part; bf16_t* proj;
    DEV void operator()(int row, int col0, const f32x4 (&acc)[4]) const {
        float ss = 0.f;
#pragma unroll
        for (int i = 0; i < 4; ++i) { const f32x4 q = *(const f32x4*)(part + row * 16 + i * 4); ss += q[0] + q[1] + q[2] + q[3]; }
        const float r = rsqrtf(ss * (1.f / 1024.f) + 1e-6f);
#pragma unroll
        for (int n = 0; n < 4; ++n) *(uint2*)(proj + (size_t)row * PROJ_LD + col0 + n * 16) = pack4(acc[n] * r);
    }
};

DEV void attn_item(const Params& p, int layer, int item, unsigned char* smem) {
    const int tid = tidx(), lane = tid & 63, wid = tid >> 6, fr = lane & 15, fq = lane >> 4;
    bf16_t* Ks = (bf16_t*)smem;
    constexpr int VTS = 268;
    bf16_t* Vt = Ks + 256 * 72;
    const bf16_t* proj = (const bf16_t*)(p.ws + WS_PROJ);
    bf16_t* br = (bf16_t*)(p.ws + WS_BR);
    int b, head, qrow0, nq;
    const bool prompt = item < 512;
    if (prompt) { b = item >> 6; head = (item >> 4) & 3; qrow0 = b * 2048 + (item & 15) * 128; nq = 128; }
    else { const int it = item - 512; b = it >> 2; head = it & 3; qrow0 = NTOK_P + b * 8; nq = 8; }
    const int nst = prompt ? 2 : (wid == 0 ? 1 : 0);
    bf16x8 qfp[2][2]; uint2 gtp[2][4];
#pragma unroll
    for (int s2 = 0; s2 < 2; ++s2) {
        if (s2 < nst) {
            const int st = prompt ? wid * 2 + s2 : 0;
            const int ql = st * 16 + fr;
            const int qr = qrow0 + (ql < nq ? ql : 0);
            qfp[s2][0] = ld8(proj + (size_t)qr * PROJ_LD + C_XQ + head * 64 + fq * 8);
            qfp[s2][1] = ld8(proj + (size_t)qr * PROJ_LD + C_XQ + head * 64 + 32 + fq * 8);
#pragma unroll
            for (int dt = 0; dt < 4; ++dt) gtp[s2][dt] = *(const uint2*)(proj + (size_t)qr * PROJ_LD + C_GATE + 768 + head * 64 + dt * 16 + fq * 4);
        }
    }
    __syncthreads();
    if (prompt) {
        const bf16_t* kg = (const bf16_t*)(p.ws + WS_KB) + ((size_t)(layer * 8 + b) * 256) * 256 + head * 64;
        const bf16_t* vg = (const bf16_t*)(p.ws + WS_VB) + ((size_t)(layer * 8 + b) * 256) * 256 + head * 64;
#pragma unroll
        for (int i = 0; i < 8; ++i) {
            const int idx = i * 256 + tid, m = idx >> 3, sg = idx & 7;
            const uint4 kv = *(const uint4*)(kg + (size_t)m * 256 + sg * 8);
            *(uint4*)(Ks + m * 72 + sg * 8) = kv;
            const uint4 vv = *(const uint4*)(vg + (size_t)m * 256 + sg * 8);
            bf16_t* vd = Vt + (sg * 8) * VTS + m;
            vd[0 * VTS] = (bf16_t)(vv.x & 0xffff); vd[1 * VTS] = (bf16_t)(vv.x >> 16);
            vd[2 * VTS] = (bf16_t)(vv.y & 0xffff); vd[3 * VTS] = (bf16_t)(vv.y >> 16);
            vd[4 * VTS] = (bf16_t)(vv.z & 0xffff); vd[5 * VTS] = (bf16_t)(vv.z >> 16);
            vd[6 * VTS] = (bf16_t)(vv.w & 0xffff); vd[7 * VTS] = (bf16_t)(vv.w >> 16);
        }
    } else {
        const float* kg = p.in[I_CK] + ((size_t)(layer * 128 + b) * 256) * 256 + head * 64;
        const float* vg = p.in[I_CV] + ((size_t)(layer * 128 + b) * 256) * 256 + head * 64;
#pragma unroll 8
        for (int i = 0; i < 16; ++i) {
            const int idx = i * 256 + tid, m = idx >> 4, sg = idx & 15;
            const float4 kv = *(const float4*)(kg + (size_t)m * 256 + sg * 4);
            *(uint2*)(Ks + m * 72 + sg * 4) = make_uint2(pack2(kv.x, kv.y), pack2(kv.z, kv.w));
            const float4 vv = *(const float4*)(vg + (size_t)m * 256 + sg * 4);
            bf16_t* vd = Vt + (sg * 4) * VTS + m;
            vd[0] = f2bf(vv.x); vd[VTS] = f2bf(vv.y); vd[2 * VTS] = f2bf(vv.z); vd[3 * VTS] = f2bf(vv.w);
        }
    }
    __syncthreads();
#pragma unroll
    for (int s2 = 0; s2 < 2; ++s2) {
        if (s2 >= nst) break;
        const int st = prompt ? wid * 2 + s2 : 0;
        const int ql = st * 16 + fr;
        const bool valid = ql < nq;
        const int qr = qrow0 + (valid ? ql : 0);
        bf16x8 qf[2];
        qf[0] = qfp[s2][0]; qf[1] = qfp[s2][1];
        f32x4 s[16];
#pragma unroll
        for (int mt = 0; mt < 16; ++mt) {
            s[mt] = (f32x4){0.f, 0.f, 0.f, 0.f};
#pragma unroll
            for (int ks = 0; ks < 2; ++ks) s[mt] = mfma16(ld8(Ks + (mt * 16 + fr) * 72 + ks * 32 + fq * 8), qf[ks], s[mt]);
            if ((mt & 3) == 3) __builtin_amdgcn_sched_barrier(0);
        }
        float mx = -1e30f;
#pragma unroll
        for (int mt = 0; mt < 16; ++mt) mx = fmaxf(fmaxf(fmaxf(s[mt][0], s[mt][1]), fmaxf(s[mt][2], s[mt][3])), mx);
        mx = fmaxf(mx, __shfl_xor(mx, 16)); mx = fmaxf(mx, __shfl_xor(mx, 32));
        float sum = 0.f;
#pragma unroll
        for (int mt = 0; mt < 16; ++mt)
#pragma unroll
            for (int j = 0; j < 4; ++j) { const float e = __expf((s[mt][j] - mx) * 0.125f); s[mt][j] = e; sum += e; }
        sum += __shfl_xor(sum, 16); sum += __shfl_xor(sum, 32);
        f32x4 o[4];
#pragma unroll
        for (int dt = 0; dt < 4; ++dt) o[dt] = (f32x4){0.f, 0.f, 0.f, 0.f};
#pragma unroll
        for (int t = 0; t < 8; ++t) {
            const u32x4 pu = {pack2(s[2 * t][0], s[2 * t][1]), pack2(s[2 * t][2], s[2 * t][3]), pack2(s[2 * t + 1][0], s[2 * t + 1][1]), pack2(s[2 * t + 1][2], s[2 * t + 1][3])};
            const bf16x8 pf = __builtin_bit_cast(bf16x8, pu);
#pragma unroll
            for (int dt = 0; dt < 4; ++dt) {
                const bf16_t* vp = Vt + (dt * 16 + fr) * VTS + (2 * t) * 16 + fq * 4;
                const u32x2 v0 = *(const u32x2*)vp, v1 = *(const u32x2*)(vp + 16);
                const u32x4 vu = {v0[0], v0[1], v1[0], v1[1]};
                o[dt] = mfma16(__builtin_bit_cast(bf16x8, vu), pf, o[dt]);
            }
            __builtin_amdgcn_sched_barrier(0);
        }
        if (valid) {
            const float inv = 1.f / sum;
#pragma unroll
            for (int dt = 0; dt < 4; ++dt) {
                const int col = 768 + head * 64 + dt * 16 + fq * 4;
                const uint2 gt = gtp[s2][dt];
                f32x4 v;
                v[0] = o[dt][0] * inv * silu_f(bflo(gt.x)); v[1] = o[dt][1] * inv * silu_f(bfhi(gt.x));
                v[2] = o[dt][2] * inv * silu_f(bflo(gt.y)); v[3] = o[dt][3] * inv * silu_f(bfhi(gt.y));
                *(uint2*)(br + (size_t)qr * 1024 + col) = pack4(v);
            }
        }
    }
}

template <int CV, int R, int TK>
DEV void gdn_prep(const Params& p, int rowbase, int tseq0, int hist_b, int h,
                  bf16_t* W, bf16_t* UT, bf16_t* QD, bf16_t* KDT, bf16_t* AQK, float* EGL, unsigned char* smem) {
    const int tid = tidx(), lane = tid & 63, wid = tid >> 6, fr = lane & 15, fq = lane >> 4;
    float* As = (float*)smem;
    float* Gs = As + 64 * 64;
    float* Bs = Gs + 64;
    float* Es = Bs + 64;
    bf16_t* qs = (bf16_t*)(Es + 64);
    bf16_t* ks = qs + 64 * 136;
    bf16_t* vs = ks + 64 * 136;
    const bf16_t* proj = (const bf16_t*)(p.ws + WS_PROJ);
    const float* gb = (const float*)(p.ws + WS_G);
    const float* bb = (const float*)(p.ws + WS_BETA);
    const int seqrow0 = rowbase - tseq0;
    __syncthreads();
    float G = (lane < CV) ? gb[(rowbase + lane) * 6 + h] : 0.f;
#pragma unroll
    for (int d = 1; d < 64; d <<= 1) { const float t = __shfl_up(G, d); if (lane >= d) G += t; }
    const float Glast = __shfl(G, 63);
    if (wid == 0) {
        const float be = (lane < CV) ? bb[(rowbase + lane) * 6 + h] : 0.f;
        Gs[lane] = G; Bs[lane] = be; Es[lane] = be * expf(G);
    }
    {
        const int grp = tid & 15, rl = tid >> 4;
        const float* cw = p.in[I_CWA];
        constexpr int RPT = 4;
        if (rl * RPT < R) {
#pragma unroll 1
            for (int sec = 0; sec < 3; ++sec) {
                const int col = sec * 768 + h * 128 + grp * 8;
                f32x4 w0[4], w1[4];
#pragma unroll
                for (int j = 0; j < 4; ++j) { w0[j] = *(const f32x4*)(cw + j * 2304 + col); w1[j] = *(const f32x4*)(cw + j * 2304 + col + 4); }
                bf16_t* dstb = (sec == 0 ? qs : (sec == 1 ? ks : vs)) + grp * 8;
                float xr[RPT + 3][8];
#pragma unroll
                for (int i = 0; i < RPT + 3; ++i) {
                    const int rr = rl * RPT - 3 + i;
                    const int ts = tseq0 + rr;
                    if (rr >= CV) {
#pragma unroll
                        for (int c = 0; c < 8; ++c) xr[i][c] = 0.f;
                    } else if (ts >= 0) {
                        const u32x4 u = *(const u32x4*)(proj + (size_t)(seqrow0 + ts) * PROJ_LD + col);
#pragma unroll
                        for (int c = 0; c < 4; ++c) { xr[i][2 * c] = bflo(u[c]); xr[i][2 * c + 1] = bfhi(u[c]); }
                    } else if (hist_b >= 0) {
                        const f32x4 h0 = *(const f32x4*)(p.in[I_SGC] + (size_t)(hist_b * 3 + 3 + ts) * 2304 + col);
                        const f32x4 h1 = *(const f32x4*)(p.in[I_SGC] + (size_t)(hist_b * 3 + 3 + ts) * 2304 + col + 4);
#pragma unroll
                        for (int c = 0; c < 4; ++c) { xr[i][c] = h0[c]; xr[i][4 + c] = h1[c]; }
                    } else {
#pragma unroll
                        for (int c = 0; c < 8; ++c) xr[i][c] = 0.f;
                    }
                }
#pragma unroll
                for (int i = 0; i < RPT; ++i) {
                    const int r = rl * RPT + i;
                    const bool rv = r < CV;
                    float a[8];
#pragma unroll
                    for (int c = 0; c < 4; ++c) {
                        a[c] = w0[0][c] * xr[i][c] + w0[1][c] * xr[i + 1][c] + w0[2][c] * xr[i + 2][c] + w0[3][c] * xr[i + 3][c];
                        a[4 + c] = w1[0][c] * xr[i][4 + c] + w1[1][c] * xr[i + 1][4 + c] + w1[2][c] * xr[i + 2][4 + c] + w1[3][c] * xr[i + 3][4 + c];
                    }
                    float ss = 0.f;
#pragma unroll
                    for (int c = 0; c < 8; ++c) { a[c] = rv ? silu_f(a[c]) : 0.f; ss += a[c] * a[c]; }
                    float scl = 1.f;
                    if (sec < 2) {
                        ss += __shfl_xor(ss, 1); ss += __shfl_xor(ss, 2); ss += __shfl_xor(ss, 4); ss += __shfl_xor(ss, 8);
                        scl = rsqrtf(ss + 1e-6f) * (sec == 0 ? 0.08838834764831845f : 1.f);
                    }
                    const u32x4 o = {pack2(a[0] * scl, a[1] * scl), pack2(a[2] * scl, a[3] * scl), pack2(a[4] * scl, a[5] * scl), pack2(a[6] * scl, a[7] * scl)};
                    *(u32x4*)(dstb + r * 136) = o;
                    if (sec == 0) {
                        const float s2 = scl * expf(__shfl(G, r));
                        const u32x4 o2 = {pack2(a[0] * s2, a[1] * s2), pack2(a[2] * s2, a[3] * s2), pack2(a[4] * s2, a[5] * s2), pack2(a[6] * s2, a[7] * s2)};
                        *(u32x4*)(QD + r * 128 + grp * 8) = o2;
                    }
                }
            }
        }
    }
    __syncthreads();
    if (wid * 16 < R) {
        const int mt = wid;
        bf16x8 ka[4], qa[4];
#pragma unroll
        for (int k4 = 0; k4 < 4; ++k4) { ka[k4] = ld8(ks + (mt * 16 + fr) * 136 + k4 * 32 + fq * 8); qa[k4] = ld8(qs + (mt * 16 + fr) * 136 + k4 * 32 + fq * 8); }
#pragma unroll
        for (int nt = 0; nt < TK / 16; ++nt) {
            f32x4 akk = (f32x4){0.f, 0.f, 0.f, 0.f}, aqk = (f32x4){0.f, 0.f, 0.f, 0.f};
            if (nt <= mt) {
#pragma unroll
                for (int k4 = 0; k4 < 4; ++k4) { const bf16x8 kb = ld8(ks + (nt * 16 + fr) * 136 + k4 * 32 + fq * 8); akk = mfma16(ka[k4], kb, akk); aqk = mfma16(qa[k4], kb, aqk); }
            }
            const int jc = nt * 16 + fr;
            const float gj = Gs[jc];
#pragma unroll
            for (int j = 0; j < 4; ++j) {
                const int i = mt * 16 + fq * 4 + j;
                const float dec = (jc <= i) ? __expf(Gs[i] - gj) : 0.f;
                As[i * 64 + jc] = (jc < i) ? Bs[i] * akk[j] * dec : 0.f;
                AQK[i * TK + jc] = f2bf(aqk[j] * dec);
            }
        }
    }
    __syncthreads();
    {
        const int c = tid;
        int zero; asm volatile("v_mov_b32 %0, 0" : "=v"(zero));
        const bf16_t* src = ((c < 128) ? ks + c : vs + (c - 128)) + zero;
        const float* sc = ((c < 128) ? Es : Bs) + zero;
        const f32x4* Az = (const f32x4*)As + zero;
        float x[CV];
        constexpr int RB = 8;
#pragma unroll
        for (int ib = 0; ib < CV / RB; ++ib) {
            float a[RB];
#pragma unroll
            for (int r = 0; r < RB; ++r) a[r] = bf2f(src[(ib * RB + r) * 136]) * sc[ib * RB + r];
#pragma unroll
            for (int j4 = 0; j4 < ib * RB / 4; ++j4) {
#pragma unroll
                for (int r = 0; r < RB; ++r) {
                    const f32x4 av = Az[(ib * RB + r) * 16 + j4];
                    a[r] -= av[0] * x[j4 * 4] + av[1] * x[j4 * 4 + 1] + av[2] * x[j4 * 4 + 2] + av[3] * x[j4 * 4 + 3];
                }
            }
            {
                f32x4 d0[RB], d1[RB];
#pragma unroll
                for (int r = 0; r < RB; ++r) { d0[r] = Az[(ib * RB + r) * 16 + ib * 2]; d1[r] = Az[(ib * RB + r) * 16 + ib * 2 + 1]; }
#pragma unroll
                for (int r = 0; r < RB; ++r) {
                    float t = a[r];
#pragma unroll
                    for (int j = 0; j < r; ++j) t -= (j < 4 ? d0[r][j & 3] : d1[r][j & 3]) * x[ib * RB + j];
                    x[ib * RB + r] = t;
                }
            }
            __builtin_amdgcn_sched_barrier(0);
        }
        if (c >= 128) {
            bf16_t* ud = UT + (c - 128) * R;
#pragma unroll
            for (int i8 = 0; i8 < R / 8; ++i8) {
                unsigned wv[4];
#pragma unroll
                for (int k2 = 0; k2 < 4; ++k2) { const int i = i8 * 8 + k2 * 2; wv[k2] = (i < CV) ? pack2(x[i < CV ? i : 0], x[(i + 1) < CV ? (i + 1) : 0]) : 0u; }
                *(uint4*)(ud + i8 * 8) = make_uint4(wv[0], wv[1], wv[2], wv[3]);
            }
        } else {
#pragma unroll
            for (int i = 0; i < R; ++i) qs[i * 136 + c] = (i < CV) ? f2bf(x[i < CV ? i : 0]) : (bf16_t)0;
        }
    }
    __syncthreads();
    for (int idx = tid; idx < R * 16; idx += 256) { const int r = idx >> 4, sg = idx & 15; *(uint4*)(W + r * 128 + sg * 8) = *(const uint4*)(qs + r * 136 + sg * 8); }
    {
        const int cc = tid & 127, half = tid >> 7;
        constexpr int HT = TK / 2;
        unsigned wv[HT / 2];
#pragma unroll
        for (int k2 = 0; k2 < HT / 2; ++k2) {
            const int t = half * HT + 2 * k2;
            const float a = (t < CV) ? bf2f(ks[t * 136 + cc]) * __expf(Glast - Gs[t]) : 0.f;
            const float b = (t + 1 < CV) ? bf2f(ks[(t + 1) * 136 + cc]) * __expf(Glast - Gs[t + 1]) : 0.f;
            wv[k2] = pack2(a, b);
        }
#pragma unroll
        for (int q4 = 0; q4 < HT / 8; ++q4) *(uint4*)(KDT + cc * TK + half * HT + q4 * 8) = make_uint4(wv[q4 * 4], wv[q4 * 4 + 1], wv[q4 * 4 + 2], wv[q4 * 4 + 3]);
    }
    if (tid == 0) *EGL = expf(Glast);
}

template <int MT, int R, int TK>
DEV void gdn_scan(int nchunks, int cstride  , const bf16_t* W0, const bf16_t* UT0, const bf16_t* QD0, const bf16_t* KDT0,
                  const bf16_t* AQK0, const float* EGL0, const float* S0, float* Sout, bf16_t* obase, int nvalid, int s, unsigned char* smem) {
    const int tid = tidx(), lane = tid & 63, wid = tid >> 6, fr = lane & 15, fq = lane >> 4;
    constexpr int VLD = TK + 8;
    bf16_t* ST = (bf16_t*)smem;
    bf16_t* VN = ST + 32 * 136;
    bf16_t* OT = VN + 32 * 72;
    f32x4 Sacc[2][2];
#pragma unroll
    for (int m2 = 0; m2 < 2; ++m2)
#pragma unroll
        for (int nt = 0; nt < 2; ++nt)
#pragma unroll
            for (int j = 0; j < 4; ++j) Sacc[m2][nt][j] = S0 ? S0[((2 * wid + m2) * 16 + fq * 4 + j) * 128 + s * 32 + nt * 16 + fr] : 0.f;
    __syncthreads();
    for (int i = tid; i < 32 * VLD / 2; i += 256) ((unsigned*)VN)[i] = 0u;
#pragma unroll
    for (int m2 = 0; m2 < 2; ++m2)
#pragma unroll
        for (int nt = 0; nt < 2; ++nt) *(uint2*)(ST + (nt * 16 + fr) * 136 + (2 * wid + m2) * 16 + fq * 4) = pack4(Sacc[m2][nt]);
    __syncthreads();
    constexpr int K2 = TK / 32;
    auto ldf = [&](int n, bf16x8 (&kf)[2][K2], bf16x8 (&wf)[4], bf16x8 (&qf)[4], bf16x8 (&af)[K2], u32x2 (&uu)[2], float& egl) {
        const size_t it = (size_t)n * cstride;
        const bf16_t* W = W0 + it * (R * 128); const bf16_t* UT = UT0 + it * (128 * R); const bf16_t* QD = QD0 + it * (R * 128);
        const bf16_t* KDT = KDT0 + it * (128 * TK); const bf16_t* AQK = AQK0 + it * (R * TK);
        egl = EGL0[it];
        if (wid < MT) {
#pragma unroll
            for (int k4 = 0; k4 < 4; ++k4) wf[k4] = ld8(W + (wid * 16 + fr) * 128 + k4 * 32 + fq * 8);
#pragma unroll
            for (int nt = 0; nt < 2; ++nt) uu[nt] = *(const u32x2*)(UT + (s * 32 + nt * 16 + fr) * R + wid * 16 + fq * 4);
        }
#pragma unroll
        for (int m2 = 0; m2 < 2; ++m2)
#pragma unroll
            for (int k2 = 0; k2 < K2; ++k2) kf[m2][k2] = ld8(KDT + ((2 * wid + m2) * 16 + fr) * TK + k2 * 32 + fq * 8);
        if (wid < MT) {
#pragma unroll
            for (int k4 = 0; k4 < 4; ++k4) qf[k4] = ld8(QD + (wid * 16 + fr) * 128 + k4 * 32 + fq * 8);
#pragma unroll
            for (int k2 = 0; k2 < K2; ++k2) af[k2] = ld8(AQK + (wid * 16 + fr) * TK + k2 * 32 + fq * 8);
        }
    };
    auto flush_o = [&](int n) {
        const int t = tid >> 2, sg = tid & 3;
        if (t < nvalid) *(u32x4*)(obase + (size_t)(n * 64 + t) * 768 + sg * 8) = *(const u32x4*)(OT + t * 40 + sg * 8);
    };
    auto comp = [&](int n, const bf16x8 (&kf)[2][K2], const bf16x8 (&wf)[4], const bf16x8 (&qf)[4], const bf16x8 (&af)[K2], const u32x2 (&uu)[2], float egl) {
        f32x4 oacc[2];
        if (wid < MT) {
            bf16x8 sf[2][4];
#pragma unroll
            for (int nt = 0; nt < 2; ++nt)
#pragma unroll
                for (int k4 = 0; k4 < 4; ++k4) sf[nt][k4] = ld8(ST + (nt * 16 + fr) * 136 + k4 * 32 + fq * 8);
#pragma unroll
            for (int nt = 0; nt < 2; ++nt) {
                f32x4 vacc = (f32x4){0.f, 0.f, 0.f, 0.f};
#pragma unroll
                for (int k4 = 0; k4 < 4; ++k4) vacc = mfma16(wf[k4], sf[nt][k4], vacc);
                f32x4 vn;
                vn[0] = bflo(uu[nt][0]) - vacc[0]; vn[1] = bfhi(uu[nt][0]) - vacc[1]; vn[2] = bflo(uu[nt][1]) - vacc[2]; vn[3] = bfhi(uu[nt][1]) - vacc[3];
                *(uint2*)(VN + (nt * 16 + fr) * VLD + wid * 16 + fq * 4) = pack4(vn);
            }
#pragma unroll
            for (int nt = 0; nt < 2; ++nt) {
                oacc[nt] = (f32x4){0.f, 0.f, 0.f, 0.f};
#pragma unroll
                for (int k4 = 0; k4 < 4; ++k4) oacc[nt] = mfma16(qf[k4], sf[nt][k4], oacc[nt]);
            }
        }
        __syncthreads();
        if (n > 0) flush_o(n - 1);
        bf16x8 vf[2][K2];
#pragma unroll
        for (int nt = 0; nt < 2; ++nt)
#pragma unroll
            for (int k2 = 0; k2 < K2; ++k2) vf[nt][k2] = ld8(VN + (nt * 16 + fr) * VLD + k2 * 32 + fq * 8);
#pragma unroll
        for (int m2 = 0; m2 < 2; ++m2)
#pragma unroll
            for (int nt = 0; nt < 2; ++nt) {
                f32x4 a = Sacc[m2][nt] * egl;
#pragma unroll
                for (int k2 = 0; k2 < K2; ++k2) a = mfma16(kf[m2][k2], vf[nt][k2], a);
                Sacc[m2][nt] = a;
                *(uint2*)(ST + (nt * 16 + fr) * 136 + (2 * wid + m2) * 16 + fq * 4) = pack4(a);
            }
        __syncthreads();
        if (wid < MT) {
#pragma unroll
            for (int nt = 0; nt < 2; ++nt) {
#pragma unroll
                for (int k2 = 0; k2 < K2; ++k2) oacc[nt] = mfma16(af[k2], vf[nt][k2], oacc[nt]);
#pragma unroll
                for (int j = 0; j < 4; ++j) OT[(wid * 16 + fq * 4 + j) * 40 + nt * 16 + fr] = f2bf(oacc[nt][j]);
            }
        }
    };
    {
        bf16x8 kfA[2][K2], wfA[4], qfA[4], afA[K2]; u32x2 uuA[2]; float eglA;
        bf16x8 kfB[2][K2], wfB[4], qfB[4], afB[K2]; u32x2 uuB[2]; float eglB;
        ldf(0, kfA, wfA, qfA, afA, uuA, eglA);
        for (int n = 0; n < nchunks; n += 2) {
            ldf(n + 1 < nchunks ? n + 1 : nchunks - 1, kfB, wfB, qfB, afB, uuB, eglB);
            comp(n, kfA, wfA, qfA, afA, uuA, eglA);
            if (n + 1 < nchunks) {
                ldf(n + 2 < nchunks ? n + 2 : nchunks - 1, kfA, wfA, qfA, afA, uuA, eglA);
                comp(n + 1, kfB, wfB, qfB, afB, uuB, eglB);
            }
        }
        __syncthreads();
        flush_o(nchunks - 1);
    }
#pragma unroll
    for (int m2 = 0; m2 < 2; ++m2)
#pragma unroll
        for (int nt = 0; nt < 2; ++nt)
#pragma unroll
            for (int j = 0; j < 4; ++j) Sout[((2 * wid + m2) * 16 + fq * 4 + j) * 128 + s * 32 + nt * 16 + fr] = Sacc[m2][nt][j];
}

DEV void phase_gemm0(const Params& p, unsigned char* smem) {
    EpiA ea{(const float*)(p.ws + WS_RSQ), (bf16_t*)(p.ws + WS_PROJ), (float*)(p.ws + WS_BETA), (float*)(p.ws + WS_G), p.in[I_ALOG], p.in[I_DTB], p.out + O_GCP, p.out + O_GCS};
    EpiA2 ea2{(const float*)(p.ws + WS_RSQ), (bf16_t*)(p.ws + WS_PROJ), p.out + O_GCP, p.out + O_GCS};
    EpiM em{(const float*)(p.ws + WS_RSQM), p.out + O_MK, p.out + O_MV, (bf16_t*)(p.ws + WS_KB), (bf16_t*)(p.ws + WS_VB)};
    for (int t = blockIdx.x; t < 128 + 136 + 136 * 28; t += gridDim.x) {
        if (t < 128) gemm_tile<4>((const bf16_t*)(p.ws + WS_MEMB), (const bf16_t*)(p.ws + WS_WTM), (t >> 3) * 128, (t & 7) * 128, smem, em);
        else if (t < 264) gemm_tile<4>((const bf16_t*)(p.ws + WS_XB), (const bf16_t*)(p.ws + WS_WTA), (t - 128) * 128, 28 * 128, smem, ea);
        else { const int u = t - 264; gemm_tile<4, true>((const bf16_t*)(p.ws + WS_XB), (const bf16_t*)(p.ws + WS_WTA), (u / 28) * 128, (u % 28) * 128, smem, ea2); }
    }
}

DEV void phase_gdnprep_attn(const Params& p, unsigned char* smem, int* sh, int slot = 0) {
    unsigned* cnt = (unsigned*)(p.ws + WS_CNT) + slot;
    unsigned char* yb = (unsigned char*)p.out;
    for (;;) {
        const int it = next_item(cnt, sh);
        if (it >= 1536 + 768 + 1024) break;
        if (it < 1536) {
            const int h = it % 6, bn = it / 6, b = bn >> 5, n = bn & 31;
            gdn_prep<64, 64, 64>(p, b * 2048 + n * 64, n * 64, -1, h,
                                 (bf16_t*)(yb + Y_WP) + (size_t)it * 8192, (bf16_t*)(yb + Y_UTP) + (size_t)it * 8192, (bf16_t*)(p.ws + WS_QDP) + (size_t)it * 8192,
                                 (bf16_t*)(p.ws + WS_KDTP) + (size_t)it * 8192, (bf16_t*)(p.ws + WS_AQKP) + (size_t)it * 4096, (float*)(p.ws + WS_EGLP) + it, smem);
        } else if (it < 2304) {
            const int i2 = it - 1536, h = i2 % 6, b = i2 / 6;
            gdn_prep<8, 16, 32>(p, NTOK_P + b * 8, 0, b, h,
                                (bf16_t*)(yb + Y_WS) + (size_t)i2 * 2048, (bf16_t*)(yb + Y_UTS) + (size_t)i2 * 2048, (bf16_t*)(yb + Y_QDS) + (size_t)i2 * 2048,
                                (bf16_t*)(yb + Y_KDTS) + (size_t)i2 * 4096, (bf16_t*)(yb + Y_AQKS) + (size_t)i2 * 512, (float*)(p.ws + WS_EGLS) + i2, smem);
        } else { const int ai = it - 2304; attn_item(p, 0, (ai & 1) * 512 + (ai >> 1), smem); }
    }
}

DEV void scan_prompt_item(const Params& p, int q, int s, unsigned char* smem) {
    unsigned char* yb = (unsigned char*)p.out;
    bf16_t* OB = (bf16_t*)(p.ws + WS_XB);
    const int h = q % 6, b = q / 6;
    const size_t i0 = (size_t)(b * 32) * 6 + h;
    gdn_scan<4, 64, 64>(32, 6, (const bf16_t*)(yb + Y_WP) + i0 * 8192, (const bf16_t*)(yb + Y_UTP) + i0 * 8192, (const bf16_t*)(p.ws + WS_QDP) + i0 * 8192,
                        (const bf16_t*)(p.ws + WS_KDTP) + i0 * 8192, (const bf16_t*)(p.ws + WS_AQKP) + i0 * 4096, (const float*)(p.ws + WS_EGLP) + i0,
                        nullptr, p.out + O_SP + (size_t)(b * 6 + h) * 16384, OB + (size_t)(b * 2048) * 768 + h * 128 + s * 32, 64, s, smem);
}
DEV void late_wtile(const Params& p, int t, unsigned char* smem) {
    bf16_t* WtB = (bf16_t*)(p.ws + WS_WTB); bf16_t* WtO = (bf16_t*)(p.ws + WS_WTO);
    if (t < 896) prep_wtile(p.in[I_WB], 3584, p.in[I_NG] + 1024, WtB, (t >> 4) * 64, (t & 15) * 64, 0, smem);
    else { t -= 896; const int l = t >> 8, tt = t & 255; prep_wtile(p.in[I_WO] + (size_t)l * 1024 * 1024, 1024, nullptr, WtO + (size_t)l * 1024 * 1024, (tt >> 4) * 64, (tt & 15) * 64, 0, smem); }
}
DEV void phase_scan(const Params& p, unsigned char* smem, int* sh, int slot = 1) {
    unsigned* cnt = (unsigned*)(p.ws + WS_CNT) + slot;
    unsigned char* yb = (unsigned char*)p.out;
    bf16_t* OB = (bf16_t*)(p.ws + WS_XB);
    if (gridDim.x >= 192) {
        if (blockIdx.x < 192) { const int x = blockIdx.x & 7, j = blockIdx.x >> 3; scan_prompt_item(p, (j >> 2) * 8 + x, j & 3, smem); }
    } else {
        for (int it = blockIdx.x; it < 192; it += gridDim.x) scan_prompt_item(p, it >> 2, it & 3, smem);
    }
    for (;;) {
        const int i3 = next_item(cnt, sh);
        if (i3 >= 3072 + 1408) break;
        if (i3 >= 3072) { late_wtile(p, i3 - 3072, smem); continue; }
        const int s = i3 & 3, i2 = i3 >> 2, h = i2 % 6, b = i2 / 6;
        gdn_scan<1, 16, 32>(1, 0, (const bf16_t*)(yb + Y_WS) + (size_t)i2 * 2048, (const bf16_t*)(yb + Y_UTS) + (size_t)i2 * 2048, (const bf16_t*)(yb + Y_QDS) + (size_t)i2 * 2048,
                            (const bf16_t*)(yb + Y_KDTS) + (size_t)i2 * 4096, (const bf16_t*)(yb + Y_AQKS) + (size_t)i2 * 512, (const float*)(p.ws + WS_EGLS) + i2,
                            p.in[I_SG] + (size_t)i2 * 16384, p.out + O_SS + (size_t)i2 * 16384, OB + (size_t)(NTOK_P + b * 8) * 768 + h * 128 + s * 32, 8, s, smem);
    }
}

DEV void phase_gate0(const Params& p) {
    const int tid_ = tidx(); const int lane = tid_ & 63, wid = tid_ >> 6;
    const bf16_t* OB = (const bf16_t*)(p.ws + WS_XB);
    const bf16_t* proj = (const bf16_t*)(p.ws + WS_PROJ);
    bf16_t* br = (bf16_t*)(p.ws + WS_BR);
    const float2 g = *(const float2*)(p.in[I_ONG] + 2 * lane);
    for (int row = blockIdx.x * 4 + wid; row < NTOK; row += gridDim.x * 4) {
        unsigned uo[6], ug[6];
#pragma unroll
        for (int h = 0; h < 6; ++h) {
            uo[h] = *(const unsigned*)(OB + (size_t)row * 768 + h * 128 + 2 * lane);
            ug[h] = *(const unsigned*)(proj + (size_t)row * PROJ_LD + C_GATE + h * 128 + 2 * lane);
        }
        unsigned res[6];
#pragma unroll
        for (int h = 0; h < 6; ++h) {
            const float a = bflo(uo[h]), b = bfhi(uo[h]);
            const float ss = wave_sum(a * a + b * b);
            const float r = rsqrtf(ss * (1.f / 128.f) + 1e-6f);
            res[h] = pack2(a * r * g.x * silu_f(bflo(ug[h])), b * r * g.y * silu_f(bfhi(ug[h])));
        }
#pragma unroll
        for (int h = 0; h < 6; ++h) *(unsigned*)(br + (size_t)row * 1024 + h * 128 + 2 * lane) = res[h];
    }
}

DEV void phase_gemm_out(const Params& p, int layer, unsigned char* smem) {
    const bf16_t* A = (const bf16_t*)(p.ws + WS_BR); const bf16_t* Bt = (const bf16_t*)(p.ws + WS_WTO) + (size_t)layer * 1024 * 1024;
    const int G = gridDim.x, NTILES = 136 * 8, full = (NTILES / G) * G, rem = NTILES - full;
    auto mk = [&](int n0) { return EpiO{layer == 0 ? p.in[I_XP] : nullptr, layer == 0 ? p.in[I_XS] : nullptr, (bf16_t*)(p.ws + WS_XB), (float*)(p.ws + WS_PART), n0}; };
    for (int t = blockIdx.x; t < full; t += G) { const int n0 = (t & 7) * 128; gemm_tile<4>(A, Bt, (t >> 3) * 128, n0, smem, mk(n0)); }
    if (rem * 4 <= G) {
        for (int hh = blockIdx.x; hh < rem * 4; hh += G) { const int t = full + (hh >> 2), n0 = (t & 7) * 128; gemm_tile<1>(A, Bt, (t >> 3) * 128 + (hh & 3) * 32, n0, smem, mk(n0)); }
    } else if (rem * 2 <= G) {
        for (int hh = blockIdx.x; hh < rem * 2; hh += G) { const int t = full + (hh >> 1), n0 = (t & 7) * 128; gemm_tile<2>(A, Bt, (t >> 3) * 128 + (hh & 1) * 64, n0, smem, mk(n0)); }
    } else {
        for (int t = full + blockIdx.x; t < NTILES; t += G) { const int n0 = (t & 7) * 128; gemm_tile<4>(A, Bt, (t >> 3) * 128, n0, smem, mk(n0)); }
    }
}

DEV void phase_gemm1(const Params& p, unsigned char* smem) {
    EpiB2 eb{(const float*)(p.ws + WS_PART), (bf16_t*)(p.ws + WS_PROJ)};
    const bf16_t* A = (const bf16_t*)(p.ws + WS_XB); const bf16_t* Bt = (const bf16_t*)(p.ws + WS_WTB);
    const int G = gridDim.x, NTILES = 136 * 28, full = (NTILES / G) * G, rem = NTILES - full;
    for (int t = blockIdx.x; t < full; t += G) gemm_tile<4, true>(A, Bt, (t / 28) * 128, (t % 28) * 128, smem, eb);
    if (rem * 2 <= G) {
        for (int hh = blockIdx.x; hh < rem * 2; hh += G) { const int t = full + (hh >> 1); gemm_tile<2, true>(A, Bt, (t / 28) * 128 + (hh & 1) * 64, (t % 28) * 128, smem, eb); }
    } else {
        for (int t = full + blockIdx.x; t < NTILES; t += G) gemm_tile<4, true>(A, Bt, (t / 28) * 128, (t % 28) * 128, smem, eb);
    }
}

DEV void sconv_rows(const Params& p, int blk) {
    const int tid_ = tidx(); const int lane = tid_ & 63, wid = tid_ >> 6;
    const int row = blk * 4 + wid;
    const bf16_t* proj = (const bf16_t*)(p.ws + WS_PROJ);
    bf16_t* br = (bf16_t*)(p.ws + WS_BR);
    const float* cw = p.in[I_CWB];
    int t, L, b; size_t seqrow0;
    if (row < NTOK_P) { b = row >> 11; t = row & 2047; L = 2048; seqrow0 = (size_t)b * 2048; }
    else { const int rs = row - NTOK_P; b = rs >> 3; t = rs & 7; L = 8; seqrow0 = NTOK_P + (size_t)b * 8; }
    f32x4 ov[3], ul[3];
#pragma unroll
    for (int i = 0; i < 3; ++i) {
        const int c = i * 256 + lane * 4;
        f32x4 u[3];
#pragma unroll
        for (int j = 0; j < 3; ++j) {
            const int ts = t - 2 + j;
            if (ts >= 0) {
                const bf16_t* pr = proj + (seqrow0 + ts) * PROJ_LD;
                const uint2 cg = *(const uint2*)(pr + 768 + c), xs = *(const uint2*)(pr + 1536 + c);
                u[j][0] = bflo(cg.x) * bflo(xs.x); u[j][1] = bfhi(cg.x) * bfhi(xs.x); u[j][2] = bflo(cg.y) * bflo(xs.y); u[j][3] = bfhi(cg.y) * bfhi(xs.y);
            } else if (row >= NTOK_P) u[j] = *(const f32x4*)(p.in[I_SSC] + (size_t)(b * 2 + 2 + ts) * 768 + c);
            else u[j] = (f32x4){0.f, 0.f, 0.f, 0.f};
        }
        const f32x4 w0 = *(const f32x4*)(cw + c), w1 = *(const f32x4*)(cw + 768 + c), w2 = *(const f32x4*)(cw + 1536 + c);
        const f32x4 y = w0 * u[0] + w1 * u[1] + w2 * u[2];
        const bf16_t* pr = proj + (size_t)row * PROJ_LD;
        const uint2 bg = *(const uint2*)(pr + c), gt = *(const uint2*)(pr + C_GATE + c);
        ov[i][0] = bflo(bg.x) * y[0] * silu_f(bflo(gt.x)); ov[i][1] = bfhi(bg.x) * y[1] * silu_f(bfhi(gt.x));
        ov[i][2] = bflo(bg.y) * y[2] * silu_f(bflo(gt.y)); ov[i][3] = bfhi(bg.y) * y[3] * silu_f(bfhi(gt.y));
        ul[i] = u[2];
    }
#pragma unroll
    for (int i = 0; i < 3; ++i) {
        const int c = i * 256 + lane * 4;
        *(uint2*)(br + (size_t)row * 1024 + c) = pack4(ov[i]);
        if (t >= L - 2) {
            float* dst = (row < NTOK_P ? p.out + O_SCP : p.out + O_SCS) + (size_t)(b * 2 + (t - (L - 2))) * 768 + c;
            *(f32x4*)dst = ul[i];
        }
    }
}
DEV void phase_sconv_attn(const Params& p, unsigned char* smem, int* sh, int slot = 2) {
    unsigned* cnt = (unsigned*)(p.ws + WS_CNT) + slot;
    for (;;) {
        const int it = next_item(cnt, sh);
        if (it >= 1024 + NTOK / 4) break;
        if (it < 1024) attn_item(p, 1, (it & 1) * 512 + (it >> 1), smem);
        else sconv_rows(p, it - 1024);
    }
}

DEV void phase_final(const Params& p) {
    const int tid_ = tidx(); const int lane = tid_ & 63, wid = tid_ >> 6;
    const float* part = (const float*)(p.ws + WS_PART);
    const bf16_t* xb = (const bf16_t*)(p.ws + WS_XB);
    const float* g = p.in[I_FNG];
    float* y = p.out + O_Y;
    for (int row = blockIdx.x * 4 + wid; row < NTOK; row += gridDim.x * 4) {
        float ss = (lane < 16) ? part[row * 16 + lane] : 0.f;
        ss = wave_sum(ss);
        const float r = rsqrtf(ss * (1.f / 1024.f) + 1e-6f);
#pragma unroll
        for (int i = 0; i < 4; ++i) {
            const uint2 u = ((const uint2*)(xb + (size_t)row * 1024))[i * 64 + lane];
            const f32x4 gg = ((const f32x4*)g)[i * 64 + lane];
            f32x4 v = {bflo(u.x), bfhi(u.x), bflo(u.y), bfhi(u.y)};
            ((f32x4*)(y + (size_t)row * 1024))[i * 64 + lane] = v * r * gg;
        }
    }
}

DEV void run_phase(const Params& p, int ph, unsigned char* smem, int* sh) {
    switch (ph) {
    case 0: phase_prep(p, smem); break;
    case 1: phase_gemm0(p, smem); break;
    case 2: phase_gdnprep_attn(p, smem, sh); break;
    case 3: phase_scan(p, smem, sh); break;
    case 4: phase_gate0(p); break;
    case 5: phase_gemm_out(p, 0, smem); break;
    case 6: phase_gemm1(p, smem); break;
    case 7: phase_sconv_attn(p, smem, sh); break;
    case 8: phase_gemm_out(p, 1, smem); break;
    default: phase_final(p); break;
    }
}

extern __shared__ __attribute__((aligned(16))) unsigned char dyn_smem[];

#if !defined(ONLY) && !MULTI
__global__ void __launch_bounds__(256, 2) k_mega(Params p) {
    __shared__ int sh_item[4];
    cg::grid_group grid = cg::this_grid();
    __shared__ uint4 xb_words;
    if (threadIdx.x == 0) xb_words = make_uint4(0u, 0u, 0u, 0u);
    __syncthreads();
    XcdBarrier xb = xcd_barrier_post((unsigned*)(p.ws + WS_XBAR), (volatile LAS unsigned*)&xb_words);
    if (p.ws == nullptr) grid.sync();
    phase_prep(p, dyn_smem); xcd_barrier(xb);
    phase_gemm0(p, dyn_smem); xcd_barrier(xb);
    phase_gdnprep_attn(p, dyn_smem, sh_item); xcd_barrier(xb);
    phase_scan(p, dyn_smem, sh_item); xcd_barrier(xb);
    phase_gate0(p); xcd_barrier(xb);
    phase_gemm_out(p, 0, dyn_smem); xcd_barrier(xb);
    phase_gemm1(p, dyn_smem); xcd_barrier(xb);
    phase_sconv_attn(p, dyn_smem, sh_item); xcd_barrier(xb);
    phase_gemm_out(p, 1, dyn_smem); xcd_barrier(xb);
    phase_final(p);
}

#endif
__global__ void __launch_bounds__(256, 2) k_phase(Params p, int ph) {
    __shared__ int sh_item[4];
#ifdef ONLY
    run_phase(p, ONLY, dyn_smem, sh_item);
#else
    run_phase(p, ph, dyn_smem, sh_item);
#endif
}

extern "C" void kernel_launch(void* const* d_in, const int* in_sizes, int n_in, void* d_out, int out_size, void* d_ws, size_t ws_size, hipStream_t stream) {
    static int grid_blocks = 0;
    if (!grid_blocks) {
        if (n_in != 20 || ws_size < WS_END) { fprintf(stderr, "kernel_launch: unexpected n_in %d / ws_size %zu (need %zu)\n", n_in, ws_size, (size_t)WS_END); grid_blocks = -1; return; }
        int dev = 0, cus = 0, per_cu = 0;
        (void)hipGetDevice(&dev);
        (void)hipDeviceGetAttribute(&cus, hipDeviceAttributeMultiprocessorCount, dev);
#if MULTI
        (void)hipFuncSetAttribute((const void*)k_phase, hipFuncAttributeMaxDynamicSharedMemorySize, LDS_BYTES);
        (void)hipOccupancyMaxActiveBlocksPerMultiprocessor(&per_cu, (const void*)k_phase, 256, LDS_BYTES);
#else
        (void)hipFuncSetAttribute((const void*)k_mega, hipFuncAttributeMaxDynamicSharedMemorySize, LDS_BYTES);
        (void)hipOccupancyMaxActiveBlocksPerMultiprocessor(&per_cu, (const void*)k_mega, 256, LDS_BYTES);
#endif
        if (per_cu < 1) per_cu = 1;
        if (per_cu > 2) per_cu = 2;
        grid_blocks = cus * per_cu;
        (void)hipGetLastError();
    }
    if (grid_blocks < 0) return;
    Params p{};
    for (int i = 0; i < 20; ++i) p.in[i] = (const float*)d_in[i];
    p.out = (float*)d_out; p.ws = (unsigned char*)d_ws;
#ifdef CLEARALL
    (void)hipMemsetAsync(d_ws, 0, WS_END, stream);
    (void)hipMemsetAsync(d_out, 0, (size_t)out_size * 4, stream);
#endif
#if MULTI
    for (int ph = 0; ph < RUNPH; ++ph) hipLaunchKernelGGL(k_phase, dim3(grid_blocks), dim3(256), LDS_BYTES, stream, p, ph);
#ifdef CLEARALL
    if (RUNPH < 6) (void)hipMemsetAsync(d_out, 0, 17825792ull * 4, stream);
#endif
#else
    (void)hipMemsetAsync((unsigned char*)d_ws + WS_XBAR, 0, XCD_BAR_WORDS * 4, stream);
    void* args[] = {&p};
    hipError_t e = hipLaunchCooperativeKernel((const void*)k_mega, dim3(grid_blocks), dim3(256), args, LDS_BYTES, stream);
    if (e != hipSuccess) fprintf(stderr, "cooperative launch failed: %s (grid %d)\n", hipGetErrorString(e), grid_blocks);
#endif
}
```

```cpp
#include <hip/hip_runtime.h>
#include <hip/hip_cooperative_groups.h>
#include <cstdio>
namespace cg = cooperative_groups;

#ifndef MULTI
#define MULTI 0
#endif
#ifndef RUNPH
#define RUNPH 10
#endif

typedef unsigned short bf16_t;
typedef short bf16x8 __attribute__((ext_vector_type(8)));
typedef float f32x4 __attribute__((ext_vector_type(4)));
typedef unsigned u32x4 __attribute__((ext_vector_type(4)));
typedef unsigned u32x2 __attribute__((ext_vector_type(2)));
typedef float f32x2 __attribute__((ext_vector_type(2)));
#define DEV __device__ __forceinline__
DEV int tidx() { int t = threadIdx.x; asm volatile("" : "+v"(t)); return t; }

constexpr int NTOK_P = 16384, NTOK = 17408, NROWS_ALL = 19456;
constexpr int PROJ_LD = 3584, NPA = 3712;
constexpr int C_GATE = 2304, C_XQ = 3328;
constexpr int LDS_BYTES = 73728;
constexpr int NPHASE = 10;

constexpr size_t WS_WTA = 0;
constexpr size_t WS_WTB = WS_WTA + 3712ull * 1024 * 2;
constexpr size_t WS_WTO = WS_WTB + 3584ull * 1024 * 2;
constexpr size_t WS_WTM = WS_WTO + 2ull * 1024 * 1024 * 2;
constexpr size_t WS_XB = WS_WTM + 1024ull * 1024 * 2;
constexpr size_t WS_BR = WS_XB + 17408ull * 1024 * 2;
constexpr size_t WS_MEMB = WS_BR + 17408ull * 1024 * 2;
constexpr size_t WS_RSQ = WS_MEMB + 2048ull * 1024 * 2;
constexpr size_t WS_RSQM = WS_RSQ + 17408ull * 4;
constexpr size_t WS_PART = WS_RSQM + 2048ull * 4;
constexpr size_t WS_BETA = WS_PART + 17408ull * 16 * 4;
constexpr size_t WS_G = WS_BETA + 17408ull * 6 * 4;
constexpr size_t WS_KB = WS_G + 17408ull * 6 * 4;
constexpr size_t WS_VB = WS_KB + 2ull * 2048 * 256 * 2;
constexpr size_t WS_CNT = WS_VB + 2ull * 2048 * 256 * 2;
constexpr size_t WS_BAR = WS_CNT + 256;
constexpr size_t WS_XBAR = WS_BAR + 256;
constexpr size_t WS_EGLP = WS_XBAR + 16384;
constexpr size_t WS_EGLS = WS_EGLP + 1536 * 4;
constexpr size_t WS_PROJ = WS_EGLS + 768 * 4;
constexpr size_t WS_QDP = WS_PROJ + 17408ull * 3584 * 2;
constexpr size_t WS_KDTP = WS_QDP + 1536ull * 16384;
constexpr size_t WS_AQKP = WS_KDTP + 1536ull * 16384;
constexpr size_t WS_END = WS_AQKP + 1536ull * 8192;
constexpr size_t Y_WP = 0;
constexpr size_t Y_UTP = Y_WP + 1536ull * 16384;
constexpr size_t Y_WS = Y_UTP + 1536ull * 16384;
constexpr size_t Y_UTS = Y_WS + 768ull * 4096;
constexpr size_t Y_QDS = Y_UTS + 768ull * 4096;
constexpr size_t Y_KDTS = Y_QDS + 768ull * 4096;
constexpr size_t Y_AQKS = Y_KDTS + 768ull * 8192;
constexpr size_t O_Y = 0, O_SP = 17825792, O_GCP = 18612224, O_SCP = 18667520, O_MK = 18679808, O_MV = 19728384,
                 O_SS = 20776960, O_GCS = 33359872, O_SCS = 34244608;

struct Params {
    const float* in[20];
    float* out;
    unsigned char* ws;
};
enum { I_XP = 0, I_XS, I_MEM, I_SG, I_SGC, I_SSC, I_CK, I_CV, I_NG, I_WA, I_CWA, I_ALOG, I_DTB, I_ONG, I_WB, I_CWB, I_MNG, I_WM, I_WO, I_FNG };

typedef __bf16 bf16v2 __attribute__((ext_vector_type(2)));
DEV unsigned pack2(float lo, float hi) { const f32x2 v = {lo, hi}; return __builtin_bit_cast(unsigned, __builtin_convertvector(v, bf16v2)); }
DEV bf16_t f2bf(float f) { return (bf16_t)(pack2(f, 0.f) & 0xffffu); }
DEV float bf2f(bf16_t h) { return __uint_as_float(((unsigned)h) << 16); }
DEV float bflo(unsigned u) { return __uint_as_float(u << 16); }
DEV float bfhi(unsigned u) { return __uint_as_float(u & 0xffff0000u); }
DEV uint2 pack4(f32x4 v) { return make_uint2(pack2(v[0], v[1]), pack2(v[2], v[3])); }
DEV float silu_f(float x) { return x * __builtin_amdgcn_rcpf(1.f + __expf(-x)); }
DEV float wave_sum(float v) {
#pragma unroll
    for (int o = 32; o > 0; o >>= 1) v += __shfl_xor(v, o);
    return v;
}
DEV f32x4 mfma16(bf16x8 a, bf16x8 b, f32x4 c) { return __builtin_amdgcn_mfma_f32_16x16x32_bf16(a, b, c, 0, 0, 0); }
DEV bf16x8 ld8(const bf16_t* p) { return *reinterpret_cast<const bf16x8*>(p); }

#define XB_TMO      128
#define XB_XCNT(j)  (256  + 64 * (j))
#define XB_XSUB(j)  (1280 + 64 * (j))
#define XB_XGEN(j)  (2304 + 64 * (j))
#define XB_TOP      3328
#define XB_TOPGEN   3392
#define XCD_BAR_WORDS 3456
#define XB_SPIN_CAP (1u << 18)
#define LAS __attribute__((address_space(3)))

__device__ __forceinline__ unsigned xb_ld(unsigned* p)              { return __hip_atomic_load(p, __ATOMIC_RELAXED, __HIP_MEMORY_SCOPE_AGENT); }
__device__ __forceinline__ unsigned xb_add(unsigned* p, unsigned v) { return __hip_atomic_fetch_add(p, v, __ATOMIC_RELAXED, __HIP_MEMORY_SCOPE_AGENT); }
__device__ __forceinline__ unsigned xb_xcc_id() { return (unsigned)__builtin_amdgcn_s_getreg((3 << 11) | 20) & 0xFu; }
#define XB_SPIN(cond, bar) do { unsigned _sp = 0; while (cond) { __builtin_amdgcn_s_sleep(1); \
    if ((++_sp & 255u) == 0u) { if (xb_ld(&(bar)[XB_TMO])) break; if (_sp > XB_SPIN_CAP) { atomicAdd(&(bar)[XB_TMO], 1u); break; } } } } while (0)

struct XcdBarrier {
    unsigned* bar; unsigned x;
    volatile LAS unsigned* st;
};

__device__ __forceinline__ XcdBarrier xcd_barrier_post(unsigned* bar, volatile LAS unsigned* st) {
    XcdBarrier b; b.bar = bar; b.x = xb_xcc_id(); b.st = st;
    if (threadIdx.x == 0) (void)xb_add(&bar[XB_XCNT(b.x)], 1u);
    return b;
}
__device__ __forceinline__ void xcd_barrier_complete(unsigned* bar, unsigned x, unsigned& nloc, unsigned& nx) {
    const unsigned G = gridDim.x * gridDim.y * gridDim.z;
    unsigned sum, cnt, mine, sp = 0u;
    for (;;) {
        sum = 0u; cnt = 0u; mine = 0u;
#pragma unroll
        for (unsigned j = 0; j < 16; ++j) { const unsigned c = xb_ld(&bar[XB_XCNT(j)]); sum += c; cnt += (c > 0u) ? 1u : 0u; mine = (j == x) ? c : mine; }
        if (sum == G) break;
        __builtin_amdgcn_s_sleep(1);
        if ((++sp & 255u) == 0u) { if (xb_ld(&bar[XB_TMO])) break; if (sp > XB_SPIN_CAP) { atomicAdd(&bar[XB_TMO], 1u); break; } }
    }
    nloc = mine > 0u ? mine : 1u; nx = cnt > 0u ? cnt : 1u;
}

__device__ __forceinline__ void xcd_barrier(const XcdBarrier& b) {
    asm volatile("s_waitcnt vmcnt(0)" ::: "memory");
    __syncthreads();
    if (threadIdx.x == 0) {
        unsigned* bar = b.bar;
        __builtin_amdgcn_s_waitcnt(0);
        unsigned nloc = b.st[0], nx = b.st[1];
        if (nloc == 0u) { xcd_barrier_complete(bar, b.x, nloc, nx); b.st[0] = nloc; b.st[1] = nx; }
        const unsigned old = xb_add(&bar[XB_XSUB(b.x)], 1u);
        const unsigned gen = old / nloc;
        if (old + 1u == (gen + 1u) * nloc) {
            __builtin_amdgcn_fence(__ATOMIC_RELEASE, "agent");
            asm volatile("s_waitcnt vmcnt(0)" ::: "memory");
            const unsigned og = xb_add(&bar[XB_TOP], 1u);
            const unsigned tg = og / nx;
            if (og + 1u == (tg + 1u) * nx) xb_add(&bar[XB_TOPGEN], 1u);
            else XB_SPIN(xb_ld(&bar[XB_TOPGEN]) == tg, bar);
            __builtin_amdgcn_fence(__ATOMIC_ACQUIRE, "agent");
            xb_add(&bar[XB_XGEN(b.x)], 1u);
            asm volatile("s_waitcnt vmcnt(0)" ::: "memory");
        } else {
            XB_SPIN(xb_ld(&bar[XB_XGEN(b.x)]) == gen, bar);
            __builtin_amdgcn_fence(__ATOMIC_ACQUIRE, "agent");
            asm volatile("s_waitcnt vmcnt(0)" ::: "memory");
        }
    }
    __syncthreads();
}


DEV void grid_barrier(unsigned* bar, unsigned target) {
    asm volatile("s_waitcnt vmcnt(0) lgkmcnt(0)" ::: "memory");
    __syncthreads();
    if (threadIdx.x == 0) {
        __builtin_amdgcn_fence(__ATOMIC_RELEASE, "agent");
        asm volatile("s_waitcnt vmcnt(0)" ::: "memory");
        __hip_atomic_fetch_add(bar, 1u, __ATOMIC_RELAXED, __HIP_MEMORY_SCOPE_AGENT);
        while (__hip_atomic_load(bar, __ATOMIC_RELAXED, __HIP_MEMORY_SCOPE_AGENT) < target) __builtin_amdgcn_s_sleep(2);
        __builtin_amdgcn_fence(__ATOMIC_ACQUIRE, "agent");
        asm volatile("s_waitcnt vmcnt(0)" ::: "memory");
    }
    __syncthreads();
}

DEV int next_item(unsigned* cnt, int* sh) {
    __syncthreads();
    if (threadIdx.x == 0) *sh = (int)atomicAdd(cnt, 1u);
    __syncthreads();
    return *sh;
}

DEV void prep_wtile(const float* __restrict__ src, int ld, const float* __restrict__ g, bf16_t* __restrict__ dst, int n0, int k0, int mode, unsigned char* smem) {
    float* tile = (float*)smem;
    const int tid = tidx();
    {
        const int n = tid & 63;
        int nn = n0 + n, col = nn;
        if (mode == 1) { col = nn < 2304 ? nn : (nn < 3584 ? nn + 12 : (nn < 3596 ? nn - 1280 : -1)); }
        float v[16];
#pragma unroll
        for (int i = 0; i < 16; ++i) {
            const int k = i * 4 + (tid >> 6);
            v[i] = (col >= 0) ? src[(size_t)(k0 + k) * ld + col] : 0.f;
        }
#pragma unroll
        for (int i = 0; i < 16; ++i) {
            const int k = i * 4 + (tid >> 6);
            tile[k * 65 + n] = g ? v[i] * g[k0 + k] : v[i];
        }
    }
    __syncthreads();
    {
        const int n = tid >> 2, ks = tid & 3;
        unsigned w[8];
#pragma unroll
        for (int i = 0; i < 8; ++i) w[i] = pack2(tile[(ks * 16 + 2 * i) * 65 + n], tile[(ks * 16 + 2 * i + 1) * 65 + n]);
        uint4* d = (uint4*)(dst + (size_t)(n0 + n) * 1024 + k0 + ks * 16);
        d[0] = make_uint4(w[0], w[1], w[2], w[3]);
        d[1] = make_uint4(w[4], w[5], w[6], w[7]);
    }
    __syncthreads();
}

DEV void phase_prep(const Params& p, unsigned char* smem) {
    const int tid = tidx(), lane = tid & 63, wid = tid >> 6;
    if (blockIdx.x == 0 && tid < 64) ((unsigned*)(p.ws + WS_CNT))[tid] = 0u;
    bf16_t* WtA = (bf16_t*)(p.ws + WS_WTA); bf16_t* WtB = (bf16_t*)(p.ws + WS_WTB);
    bf16_t* WtO = (bf16_t*)(p.ws + WS_WTO); bf16_t* WtM = (bf16_t*)(p.ws + WS_WTM);
    const int NW = 928 + 256, NR = NROWS_ALL / 4;
    for (int it = blockIdx.x; it < NW + NR; it += gridDim.x) {
        if (it < NW) {
            int t = it;
            if (t < 928) { prep_wtile(p.in[I_WA], 3596, p.in[I_NG], WtA, (t >> 4) * 64, (t & 15) * 64, 1, smem); }
            else { t -= 928; int l = t >> 7, tt = t & 127; prep_wtile(p.in[I_WM] + (size_t)l * 1024 * 512, 512, p.in[I_MNG], WtM + (size_t)l * 512 * 1024, (tt >> 4) * 64, (tt & 15) * 64, 0, smem); }
        } else {
            const int row = (it - NW) * 4 + wid;
            const float* src; bf16_t* dst; float* rs;
            if (row < NTOK_P) { src = p.in[I_XP] + (size_t)row * 1024; dst = (bf16_t*)(p.ws + WS_XB) + (size_t)row * 1024; rs = (float*)(p.ws + WS_RSQ) + row; }
            else if (row < NTOK) { src = p.in[I_XS] + (size_t)(row - NTOK_P) * 1024; dst = (bf16_t*)(p.ws + WS_XB) + (size_t)row * 1024; rs = (float*)(p.ws + WS_RSQ) + row; }
            else { src = p.in[I_MEM] + (size_t)(row - NTOK) * 1024; dst = (bf16_t*)(p.ws + WS_MEMB) + (size_t)(row - NTOK) * 1024; rs = (float*)(p.ws + WS_RSQM) + (row - NTOK); }
            float4 v[4]; float ss = 0.f;
#pragma unroll
            for (int i = 0; i < 4; ++i) { v[i] = ((const float4*)src)[i * 64 + lane]; ss += v[i].x * v[i].x + v[i].y * v[i].y + v[i].z * v[i].z + v[i].w * v[i].w; }
            ss = wave_sum(ss);
            if (lane == 0) *rs = rsqrtf(ss * (1.f / 1024.f) + 1e-6f);
#pragma unroll
            for (int i = 0; i < 4; ++i) ((uint2*)dst)[i * 64 + lane] = make_uint2(pack2(v[i].x, v[i].y), pack2(v[i].z, v[i].w));
        }
    }
}

template <int MF = 4, bool STAGED = false, class Epi>
DEV void gemm_tile(const bf16_t* __restrict__ A, const bf16_t* __restrict__ Bt, int m0, int n0, unsigned char* smem, const Epi& epi) {
    const int tid = tidx(), lane = tid & 63, wid = tid >> 6, wr = wid >> 1, wc = wid & 1;
    const int fr = lane & 15, fq = lane >> 4;
    bf16_t* As = (bf16_t*)smem;
    bf16_t* Bs = As + 2 * 128 * 64;
    f32x4 acc[MF][4];
#pragma unroll
    for (int m = 0; m < MF; ++m)
#pragma unroll
        for (int n = 0; n < 4; ++n) acc[m][n] = (f32x4){0.f, 0.f, 0.f, 0.f};
    const int lrow = tid >> 3, lseg = tid & 7;
    const bf16_t* Ag = A + (size_t)(m0 + lrow) * 1024 + lseg * 8;
    const bf16_t* Bg = Bt + (size_t)(n0 + lrow) * 1024 + lseg * 8;
    typedef __attribute__((address_space(3))) void* lds_ptr_t;
    const int gch = (lseg ^ (lrow & 7)) * 8;
    auto stage = [&](int kt, int buf) {
        bf16_t* An = As + buf * 128 * 64; bf16_t* Bn = Bs + buf * 128 * 64;
#pragma unroll
        for (int i = 0; i < 4; ++i) {
            if (i < MF) __builtin_amdgcn_global_load_lds((const unsigned*)(Ag - lseg * 8 + gch + (size_t)i * 32 * 1024 + kt * 64), (lds_ptr_t)(An + (lrow + i * 32) * 64 + lseg * 8), 16, 0, 0);
            __builtin_amdgcn_global_load_lds((const unsigned*)(Bg - lseg * 8 + gch + (size_t)i * 32 * 1024 + kt * 64), (lds_ptr_t)(Bn + (lrow + i * 32) * 64 + lseg * 8), 16, 0, 0);
        }
    };
    auto compute = [&](int buf) {
        const bf16_t* Ac = As + buf * 128 * 64 + (wr * (MF * 16) + fr) * 64;
        const bf16_t* Bc = Bs + buf * 128 * 64 + (wc * 64 + fr) * 64;
#pragma unroll
        for (int ks = 0; ks < 2; ++ks) {
            bf16x8 af[MF], bfv[4];
            const int co = ((ks * 4 + fq) ^ (fr & 7)) * 8;
#pragma unroll
            for (int m = 0; m < MF; ++m) af[m] = ld8(Ac + m * 16 * 64 + co);
#pragma unroll
            for (int n = 0; n < 4; ++n) bfv[n] = ld8(Bc + n * 16 * 64 + co);
#pragma unroll
            for (int m = 0; m < MF; ++m)
#pragma unroll
                for (int n = 0; n < 4; ++n) acc[m][n] = mfma16(bfv[n], af[m], acc[m][n]);
        }
    };
    __syncthreads();
    stage(0, 0);
#pragma unroll 1
    for (int kt = 0; kt < 16; ++kt) {
        const int cur = kt & 1;
        asm volatile("s_waitcnt vmcnt(0)" ::: "memory");
        __syncthreads();
        if (kt + 1 < 16) stage(kt + 1, cur ^ 1);
        compute(cur);
    }
    if constexpr (STAGED) {
        bf16_t* Cs = (bf16_t*)smem;
        __syncthreads();
#pragma unroll
        for (int m = 0; m < MF; ++m) {
            const int rl = wr * (MF * 16) + m * 16 + fr;
            const float sc = epi.scale(m0 + rl);
#pragma unroll
            for (int n = 0; n < 4; ++n) {
                const f32x4 v = acc[m][n] * sc;
                epi.special(m0 + rl, n0 + wc * 64 + n * 16 + fq * 4, v);
                *(uint2*)(Cs + rl * 136 + wc * 64 + n * 16 + fq * 4) = pack4(v);
            }
        }
        __syncthreads();
#pragma unroll
        for (int i = 0; i < MF * 2; ++i) {
            const int idx = i * 256 + tid, rl = idx >> 4, ch = idx & 15;
            epi.store(m0 + rl, n0 + ch * 8, *(const u32x4*)(Cs + rl * 136 + ch * 8));
        }
    } else {
#pragma unroll
        for (int m = 0; m < MF; ++m) epi(m0 + wr * (MF * 16) + m * 16 + fr, n0 + wc * 64 + fq * 4, acc[m]);
    }
}

struct EpiA {
    const float* rsq; bf16_t* proj; float* beta; float* gbuf; const float* a_log; const float* dt_bias; float* gcp; float* gcs;
    DEV void operator()(int row, int col0, const f32x4 (&acc)[4]) const {
        const float r = rsq[row];
#pragma unroll
        for (int n = 0; n < 4; ++n) {
            const int col = col0 + n * 16;
            f32x4 v = acc[n] * r;
            if (col < PROJ_LD) {
                *(uint2*)(proj + (size_t)row * PROJ_LD + col) = pack4(v);
                if (col < 2304) {
                    if (row < NTOK_P) { const int t = row & 2047; if (t >= 2045) *(f32x4*)(gcp + (size_t)((row >> 11) * 3 + (t - 2045)) * 2304 + col) = v; }
                    else { const int rs = row - NTOK_P, t = rs & 7; if (t >= 5) *(f32x4*)(gcs + (size_t)((rs >> 3) * 3 + (t - 5)) * 2304 + col) = v; }
                }
            } else {
#pragma unroll
                for (int j = 0; j < 4; ++j) {
                    const int cc = col - PROJ_LD + j;
                    if (cc < 6) beta[row * 6 + cc] = 1.f / (1.f + expf(-v[j]));
                    else if (cc < 12) { const int h = cc - 6; const float z = v[j] + dt_bias[h]; const float sp = z > 20.f ? z : log1pf(expf(z)); gbuf[row * 6 + h] = -expf(a_log[h]) * sp; }
                }
            }
        }
    }
};
struct EpiA2 {
    const float* rsq; bf16_t* proj; float* gcp; float* gcs;
    DEV float scale(int row) const { return rsq[row]; }
    DEV void special(int row, int col, f32x4 v) const {
        if (col < 2304) {
            if (row < NTOK_P) { const int t = row & 2047; if (t >= 2045) *(f32x4*)(gcp + (size_t)((row >> 11) * 3 + (t - 2045)) * 2304 + col) = v; }
            else { const int rs = row - NTOK_P, t = rs & 7; if (t >= 5) *(f32x4*)(gcs + (size_t)((rs >> 3) * 3 + (t - 5)) * 2304 + col) = v; }
        }
    }
    DEV void store(int row, int col, u32x4 c) const { *(u32x4*)(proj + (size_t)row * PROJ_LD + col) = c; }
};
struct EpiB2 {
    const float* part; bf16_t* proj;
    DEV float scale(int row) const {
        float ss = 0.f;
#pragma unroll
        for (int i = 0; i < 4; ++i) { const f32x4 q = *(const f32x4*)(part + row * 16 + i * 4); ss += q[0] + q[1] + q[2] + q[3]; }
        return rsqrtf(ss * (1.f / 1024.f) + 1e-6f);
    }
    DEV void special(int, int, f32x4) const {}
    DEV void store(int row, int col, u32x4 c) const { *(u32x4*)(proj + (size_t)row * PROJ_LD + col) = c; }
};
struct EpiM {
    const float* rsq; float* mk; float* mv; bf16_t* kb; bf16_t* vb;
    DEV void operator()(int row, int col0, const f32x4 (&acc)[4]) const {
        const float r = rsq[row];
#pragma unroll
        for (int n = 0; n < 4; ++n) {
            const int col = col0 + n * 16, l = col >> 9, e = col & 511, e2 = e & 255;
            f32x4 v = acc[n] * r;
            const size_t idx = ((size_t)l * 2048 + row) * 256 + e2;
            if (e < 256) { *(f32x4*)(mk + idx) = v; *(uint2*)(kb + idx) = pack4(v); }
            else { *(f32x4*)(mv + idx) = v; *(uint2*)(vb + idx) = pack4(v); }
        }
    }
};
struct EpiO {
    const float* xp; const float* xs; bf16_t* xb; float* part; int n0;
    DEV void operator()(int row, int col0, const f32x4 (&acc)[4]) const {
        float ss = 0.f;
#pragma unroll
        for (int n = 0; n < 4; ++n) {
            const int col = col0 + n * 16;
            f32x4 v;
            if (xp) {
                const float* xr = row < NTOK_P ? xp + (size_t)row * 1024 : xs + (size_t)(row - NTOK_P) * 1024;
                v = acc[n] + *(const f32x4*)(xr + col);
            } else {
                const uint2 u = *(const uint2*)(xb + (size_t)row * 1024 + col);
                v[0] = acc[n][0] + bflo(u.x); v[1] = acc[n][1] + bfhi(u.x); v[2] = acc[n][2] + bflo(u.y); v[3] = acc[n][3] + bfhi(u.y);
            }
            *(uint2*)(xb + (size_t)row * 1024 + col) = pack4(v);
            ss += v[0] * v[0] + v[1] * v[1] + v[2] * v[2] + v[3] * v[3];
        }
        ss += __shfl_xor(ss, 16); ss += __shfl_xor(ss, 32);
        if ((threadIdx.x & 63) < 16) part[row * 16 + (n0 >> 7) * 2 + ((threadIdx.x >> 6) & 1)] = ss;
    }
};
struct EpiB {
    const float* part; bf16_t* proj;
    DEV void operator()(int row, int col0, const f32x4 (&acc)[4]) const {
        float ss = 0.f;
#pragma unroll
        for (int i = 0; i < 4; ++i) { const f32x4 q = *(const f32x4*)(part + row * 16 + i * 4); ss += q[0] + q[1] + q[2] + q[3]; }
        const float r = rsqrtf(ss * (1.f / 1024.f) + 1e-6f);
#pragma unroll
        for (int n = 0; n < 4; ++n) *(uint2*)(proj + (size_t)row * PROJ_LD + col0 + n * 16) = pack4(acc[n] * r);
    }
};

DEV void attn_item(const Params& p, int layer, int item, unsigned char* smem) {
    const int tid = tidx(), lane = tid & 63, wid = tid >> 6, fr = lane & 15, fq = lane >> 4;
    bf16_t* Ks = (bf16_t*)smem;
    constexpr int VTS = 268;
    bf16_t* Vt = Ks + 256 * 72;
    const bf16_t* proj = (const bf16_t*)(p.ws + WS_PROJ);
    bf16_t* br = (bf16_t*)(p.ws + WS_BR);
    int b, head, qrow0, nq;
    const bool prompt = item < 512;
    if (prompt) { b = item >> 6; head = (item >> 4) & 3; qrow0 = b * 2048 + (item & 15) * 128; nq = 128; }
    else { const int it = item - 512; b = it >> 2; head = it & 3; qrow0 = NTOK_P + b * 8; nq = 8; }
    const int nst = prompt ? 2 : (wid == 0 ? 1 : 0);
    bf16x8 qfp[2][2]; uint2 gtp[2][4];
#pragma unroll
    for (int s2 = 0; s2 < 2; ++s2) {
        if (s2 < nst) {
            const int st = prompt ? wid * 2 + s2 : 0;
            const int ql = st * 16 + fr;
            const int qr = qrow0 + (ql < nq ? ql : 0);
            qfp[s2][0] = ld8(proj + (size_t)qr * PROJ_LD + C_XQ + head * 64 + fq * 8);
            qfp[s2][1] = ld8(proj + (size_t)qr * PROJ_LD + C_XQ + head * 64 + 32 + fq * 8);
#pragma unroll
            for (int dt = 0; dt < 4; ++dt) gtp[s2][dt] = *(const uint2*)(proj + (size_t)qr * PROJ_LD + C_GATE + 768 + head * 64 + dt * 16 + fq * 4);
        }
    }
    __syncthreads();
    if (prompt) {
        const bf16_t* kg = (const bf16_t*)(p.ws + WS_KB) + ((size_t)(layer * 8 + b) * 256) * 256 + head * 64;
        const bf16_t* vg = (const bf16_t*)(p.ws + WS_VB) + ((size_t)(layer * 8 + b) * 256) * 256 + head * 64;
#pragma unroll
        for (int i = 0; i < 8; ++i) {
            const int idx = i * 256 + tid, m = idx >> 3, sg = idx & 7;
            const uint4 kv = *(const uint4*)(kg + (size_t)m * 256 + sg * 8);
            *(uint4*)(Ks + m * 72 + sg * 8) = kv;
            const uint4 vv = *(const uint4*)(vg + (size_t)m * 256 + sg * 8);
            bf16_t* vd = Vt + (sg * 8) * VTS + m;
            vd[0 * VTS] = (bf16_t)(vv.x & 0xffff); vd[1 * VTS] = (bf16_t)(vv.x >> 16);
            vd[2 * VTS] = (bf16_t)(vv.y & 0xffff); vd[3 * VTS] = (bf16_t)(vv.y >> 16);
            vd[4 * VTS] = (bf16_t)(vv.z & 0xffff); vd[5 * VTS] = (bf16_t)(vv.z >> 16);
            vd[6 * VTS] = (bf16_t)(vv.w & 0xffff); vd[7 * VTS] = (bf16_t)(vv.w >> 16);
        }
    } else {
        const float* kg = p.in[I_CK] + ((size_t)(layer * 128 + b) * 256) * 256 + head * 64;
        const float* vg = p.in[I_CV] + ((size_t)(layer * 128 + b) * 256) * 256 + head * 64;
#pragma unroll 8
        for (int i = 0; i < 16; ++i) {
            const int idx = i * 256 + tid, m = idx >> 4, sg = idx & 15;
            const float4 kv = *(const float4*)(kg + (size_t)m * 256 + sg * 4);
            *(uint2*)(Ks + m * 72 + sg * 4) = make_uint2(pack2(kv.x, kv.y), pack2(kv.z, kv.w));
            const float4 vv = *(const float4*)(vg + (size_t)m * 256 + sg * 4);
            bf16_t* vd = Vt + (sg * 4) * VTS + m;
            vd[0] = f2bf(vv.x); vd[VTS] = f2bf(vv.y); vd[2 * VTS] = f2bf(vv.z); vd[3 * VTS] = f2bf(vv.w);
        }
    }
    __syncthreads();
#pragma unroll
    for (int s2 = 0; s2 < 2; ++s2) {
        if (s2 >= nst) break;
        const int st = prompt ? wid * 2 + s2 : 0;
        const int ql = st * 16 + fr;
        const bool valid = ql < nq;
        const int qr = qrow0 + (valid ? ql : 0);
        bf16x8 qf[2];
        qf[0] = qfp[s2][0]; qf[1] = qfp[s2][1];
        f32x4 s[16];
#pragma unroll
        for (int mt = 0; mt < 16; ++mt) {
            s[mt] = (f32x4){0.f, 0.f, 0.f, 0.f};
#pragma unroll
            for (int ks = 0; ks < 2; ++ks) s[mt] = mfma16(ld8(Ks + (mt * 16 + fr) * 72 + ks * 32 + fq * 8), qf[ks], s[mt]);
            if ((mt & 3) == 3) __builtin_amdgcn_sched_barrier(0);
        }
        float mx = -1e30f;
#pragma unroll
        for (int mt = 0; mt < 16; ++mt) mx = fmaxf(fmaxf(fmaxf(s[mt][0], s[mt][1]), fmaxf(s[mt][2], s[mt][3])), mx);
        mx = fmaxf(mx, __shfl_xor(mx, 16)); mx = fmaxf(mx, __shfl_xor(mx, 32));
        float sum = 0.f;
#pragma unroll
        for (int mt = 0; mt < 16; ++mt)
#pragma unroll
            for (int j = 0; j < 4; ++j) { const float e = __expf((s[mt][j] - mx) * 0.125f); s[mt][j] = e; sum += e; }
        sum += __shfl_xor(sum, 16); sum += __shfl_xor(sum, 32);
        f32x4 o[4];
#pragma unroll
        for (int dt = 0; dt < 4; ++dt) o[dt] = (f32x4){0.f, 0.f, 0.f, 0.f};
#pragma unroll
        for (int t = 0; t < 8; ++t) {
            const u32x4 pu = {pack2(s[2 * t][0], s[2 * t][1]), pack2(s[2 * t][2], s[2 * t][3]), pack2(s[2 * t + 1][0], s[2 * t + 1][1]), pack2(s[2 * t + 1][2], s[2 * t + 1][3])};
            const bf16x8 pf = __builtin_bit_cast(bf16x8, pu);
#pragma unroll
            for (int dt = 0; dt < 4; ++dt) {
                const bf16_t* vp = Vt + (dt * 16 + fr) * VTS + (2 * t) * 16 + fq * 4;
                const u32x2 v0 = *(const u32x2*)vp, v1 = *(const u32x2*)(vp + 16);
                const u32x4 vu = {v0[0], v0[1], v1[0], v1[1]};
                o[dt] = mfma16(__builtin_bit_cast(bf16x8, vu), pf, o[dt]);
            }
            __builtin_amdgcn_sched_barrier(0);
        }
        if (valid) {
            const float inv = 1.f / sum;
#pragma unroll
            for (int dt = 0; dt < 4; ++dt) {
                const int col = 768 + head * 64 + dt * 16 + fq * 4;
                const uint2 gt = gtp[s2][dt];
                f32x4 v;
                v[0] = o[dt][0] * inv * silu_f(bflo(gt.x)); v[1] = o[dt][1] * inv * silu_f(bfhi(gt.x));
                v[2] = o[dt][2] * inv * silu_f(bflo(gt.y)); v[3] = o[dt][3] * inv * silu_f(bfhi(gt.y));
                *(uint2*)(br + (size_t)qr * 1024 + col) = pack4(v);
            }
        }
    }
}

template <int CV, int R, int TK>
DEV void gdn_prep(const Params& p, int rowbase, int tseq0, int hist_b, int h,
                  bf16_t* W, bf16_t* UT, bf16_t* QD, bf16_t* KDT, bf16_t* AQK, float* EGL, unsigned char* smem) {
    const int tid = tidx(), lane = tid & 63, wid = tid >> 6, fr = lane & 15, fq = lane >> 4;
    float* As = (float*)smem;
    float* Gs = As + 64 * 64;
    float* Bs = Gs + 64;
    float* Es = Bs + 64;
    bf16_t* qs = (bf16_t*)(Es + 64);
    bf16_t* ks = qs + 64 * 136;
    bf16_t* vs = ks + 64 * 136;
    const bf16_t* proj = (const bf16_t*)(p.ws + WS_PROJ);
    const float* gb = (const float*)(p.ws + WS_G);
    const float* bb = (const float*)(p.ws + WS_BETA);
    const int seqrow0 = rowbase - tseq0;
    __syncthreads();
    float G = (lane < CV) ? gb[(rowbase + lane) * 6 + h] : 0.f;
#pragma unroll
    for (int d = 1; d < 64; d <<= 1) { const float t = __shfl_up(G, d); if (lane >= d) G += t; }
    const float Glast = __shfl(G, 63);
    if (wid == 0) {
        const float be = (lane < CV) ? bb[(rowbase + lane) * 6 + h] : 0.f;
        Gs[lane] = G; Bs[lane] = be; Es[lane] = be * expf(G);
    }
    {
        const int grp = tid & 15, rl = tid >> 4;
        const float* cw = p.in[I_CWA];
        constexpr int RPT = 4;
        if (rl * RPT < R) {
#pragma unroll 1
            for (int sec = 0; sec < 3; ++sec) {
                const int col = sec * 768 + h * 128 + grp * 8;
                f32x4 w0[4], w1[4];
#pragma unroll
                for (int j = 0; j < 4; ++j) { w0[j] = *(const f32x4*)(cw + j * 2304 + col); w1[j] = *(const f32x4*)(cw + j * 2304 + col + 4); }
                bf16_t* dstb = (sec == 0 ? qs : (sec == 1 ? ks : vs)) + grp * 8;
                float xr[RPT + 3][8];
#pragma unroll
                for (int i = 0; i < RPT + 3; ++i) {
                    const int rr = rl * RPT - 3 + i;
                    const int ts = tseq0 + rr;
                    if (rr >= CV) {
#pragma unroll
                        for (int c = 0; c < 8; ++c) xr[i][c] = 0.f;
                    } else if (ts >= 0) {
                        const u32x4 u = *(const u32x4*)(proj + (size_t)(seqrow0 + ts) * PROJ_LD + col);
#pragma unroll
                        for (int c = 0; c < 4; ++c) { xr[i][2 * c] = bflo(u[c]); xr[i][2 * c + 1] = bfhi(u[c]); }
                    } else if (hist_b >= 0) {
                        const f32x4 h0 = *(const f32x4*)(p.in[I_SGC] + (size_t)(hist_b * 3 + 3 + ts) * 2304 + col);
                        const f32x4 h1 = *(const f32x4*)(p.in[I_SGC] + (size_t)(hist_b * 3 + 3 + ts) * 2304 + col + 4);
#pragma unroll
                        for (int c = 0; c < 4; ++c) { xr[i][c] = h0[c]; xr[i][4 + c] = h1[c]; }
                    } else {
#pragma unroll
                        for (int c = 0; c < 8; ++c) xr[i][c] = 0.f;
                    }
                }
#pragma unroll
                for (int i = 0; i < RPT; ++i) {
                    const int r = rl * RPT + i;
                    const bool rv = r < CV;
                    float a[8];
#pragma unroll
                    for (int c = 0; c < 4; ++c) {
                        a[c] = w0[0][c] * xr[i][c] + w0[1][c] * xr[i + 1][c] + w0[2][c] * xr[i + 2][c] + w0[3][c] * xr[i + 3][c];
                        a[4 + c] = w1[0][c] * xr[i][4 + c] + w1[1][c] * xr[i + 1][4 + c] + w1[2][c] * xr[i + 2][4 + c] + w1[3][c] * xr[i + 3][4 + c];
                    }
                    float ss = 0.f;
#pragma unroll
                    for (int c = 0; c < 8; ++c) { a[c] = rv ? silu_f(a[c]) : 0.f; ss += a[c] * a[c]; }
                    float scl = 1.f;
                    if (sec < 2) {
                        ss += __shfl_xor(ss, 1); ss += __shfl_xor(ss, 2); ss += __shfl_xor(ss, 4); ss += __shfl_xor(ss, 8);
                        scl = rsqrtf(ss + 1e-6f) * (sec == 0 ? 0.08838834764831845f : 1.f);
                    }
                    const u32x4 o = {pack2(a[0] * scl, a[1] * scl), pack2(a[2] * scl, a[3] * scl), pack2(a[4] * scl, a[5] * scl), pack2(a[6] * scl, a[7] * scl)};
                    *(u32x4*)(dstb + r * 136) = o;
                    if (sec == 0) {
                        const float s2 = scl * expf(__shfl(G, r));
                        const u32x4 o2 = {pack2(a[0] * s2, a[1] * s2), pack2(a[2] * s2, a[3] * s2), pack2(a[4] * s2, a[5] * s2), pack2(a[6] * s2, a[7] * s2)};
                        *(u32x4*)(QD + r * 128 + grp * 8) = o2;
                    }
                }
            }
        }
    }
    __syncthreads();
    if (wid * 16 < R) {
        const int mt = wid;
        bf16x8 ka[4], qa[4];
#pragma unroll
        for (int k4 = 0; k4 < 4; ++k4) { ka[k4] = ld8(ks + (mt * 16 + fr) * 136 + k4 * 32 + fq * 8); qa[k4] = ld8(qs + (mt * 16 + fr) * 136 + k4 * 32 + fq * 8); }
#pragma unroll
        for (int nt = 0; nt < TK / 16; ++nt) {
            f32x4 akk = (f32x4){0.f, 0.f, 0.f, 0.f}, aqk = (f32x4){0.f, 0.f, 0.f, 0.f};
            if (nt <= mt) {
#pragma unroll
                for (int k4 = 0; k4 < 4; ++k4) { const bf16x8 kb = ld8(ks + (nt * 16 + fr) * 136 + k4 * 32 + fq * 8); akk = mfma16(ka[k4], kb, akk); aqk = mfma16(qa[k4], kb, aqk); }
            }
            const int jc = nt * 16 + fr;
            const float gj = Gs[jc];
#pragma unroll
            for (int j = 0; j < 4; ++j) {
                const int i = mt * 16 + fq * 4 + j;
                const float dec = (jc <= i) ? __expf(Gs[i] - gj) : 0.f;
                As[i * 64 + jc] = (jc < i) ? Bs[i] * akk[j] * dec : 0.f;
                AQK[i * TK + jc] = f2bf(aqk[j] * dec);
            }
        }
    }
    __syncthreads();
    {
        const int c = tid;
        int zero; asm volatile("v_mov_b32 %0, 0" : "=v"(zero));
        const bf16_t* src = ((c < 128) ? ks + c : vs + (c - 128)) + zero;
        const float* sc = ((c < 128) ? Es : Bs) + zero;
        const f32x4* Az = (const f32x4*)As + zero;
        float x[CV];
        constexpr int RB = 8;
#pragma unroll
        for (int ib = 0; ib < CV / RB; ++ib) {
            float a[RB];
#pragma unroll
            for (int r = 0; r < RB; ++r) a[r] = bf2f(src[(ib * RB + r) * 136]) * sc[ib * RB + r];
#pragma unroll
            for (int j4 = 0; j4 < ib * RB / 4; ++j4) {
#pragma unroll
                for (int r = 0; r < RB; ++r) {
                    const f32x4 av = Az[(ib * RB + r) * 16 + j4];
                    a[r] -= av[0] * x[j4 * 4] + av[1] * x[j4 * 4 + 1] + av[2] * x[j4 * 4 + 2] + av[3] * x[j4 * 4 + 3];
                }
            }
            {
                f32x4 d0[RB], d1[RB];
#pragma unroll
                for (int r = 0; r < RB; ++r) { d0[r] = Az[(ib * RB + r) * 16 + ib * 2]; d1[r] = Az[(ib * RB + r) * 16 + ib * 2 + 1]; }
#pragma unroll
                for (int r = 0; r < RB; ++r) {
                    float t = a[r];
#pragma unroll
                    for (int j = 0; j < r; ++j) t -= (j < 4 ? d0[r][j & 3] : d1[r][j & 3]) * x[ib * RB + j];
                    x[ib * RB + r] = t;
                }
            }
            __builtin_amdgcn_sched_barrier(0);
        }
        if (c >= 128) {
            bf16_t* ud = UT + (c - 128) * R;
#pragma unroll
            for (int i8 = 0; i8 < R / 8; ++i8) {
                unsigned wv[4];
#pragma unroll
                for (int k2 = 0; k2 < 4; ++k2) { const int i = i8 * 8 + k2 * 2; wv[k2] = (i < CV) ? pack2(x[i < CV ? i : 0], x[(i + 1) < CV ? (i + 1) : 0]) : 0u; }
                *(uint4*)(ud + i8 * 8) = make_uint4(wv[0], wv[1], wv[2], wv[3]);
            }
        } else {
#pragma unroll
            for (int i = 0; i < R; ++i) qs[i * 136 + c] = (i < CV) ? f2bf(x[i < CV ? i : 0]) : (bf16_t)0;
        }
    }
    __syncthreads();
    for (int idx = tid; idx < R * 16; idx += 256) { const int r = idx >> 4, sg = idx & 15; *(uint4*)(W + r * 128 + sg * 8) = *(const uint4*)(qs + r * 136 + sg * 8); }
    {
        const int cc = tid & 127, half = tid >> 7;
        constexpr int HT = TK / 2;
        unsigned wv[HT / 2];
#pragma unroll
        for (int k2 = 0; k2 < HT / 2; ++k2) {
            const int t = half * HT + 2 * k2;
            const float a = (t < CV) ? bf2f(ks[t * 136 + cc]) * __expf(Glast - Gs[t]) : 0.f;
            const float b = (t + 1 < CV) ? bf2f(ks[(t + 1) * 136 + cc]) * __expf(Glast - Gs[t + 1]) : 0.f;
            wv[k2] = pack2(a, b);
        }
#pragma unroll
        for (int q4 = 0; q4 < HT / 8; ++q4) *(uint4*)(KDT + cc * TK + half * HT + q4 * 8) = make_uint4(wv[q4 * 4], wv[q4 * 4 + 1], wv[q4 * 4 + 2], wv[q4 * 4 + 3]);
    }
    if (tid == 0) *EGL = expf(Glast);
}

template <int MT, int R, int TK>
DEV void gdn_scan(int nchunks, int cstride  , const bf16_t* W0, const bf16_t* UT0, const bf16_t* QD0, const bf16_t* KDT0,
                  const bf16_t* AQK0, const float* EGL0, const float* S0, float* Sout, bf16_t* obase, int nvalid, int s, unsigned char* smem) {
    const int tid = tidx(), lane = tid & 63, wid = tid >> 6, fr = lane & 15, fq = lane >> 4;
    constexpr int VLD = TK + 8;
    bf16_t* ST = (bf16_t*)smem;
    bf16_t* VN = ST + 32 * 136;
    bf16_t* OT = VN + 32 * 72;
    f32x4 Sacc[2][2];
#pragma unroll
    for (int m2 = 0; m2 < 2; ++m2)
#pragma unroll
        for (int nt = 0; nt < 2; ++nt)
#pragma unroll
            for (int j = 0; j < 4; ++j) Sacc[m2][nt][j] = S0 ? S0[((2 * wid + m2) * 16 + fq * 4 + j) * 128 + s * 32 + nt * 16 + fr] : 0.f;
    __syncthreads();
    for (int i = tid; i < 32 * VLD / 2; i += 256) ((unsigned*)VN)[i] = 0u;
#pragma unroll
    for (int m2 = 0; m2 < 2; ++m2)
#pragma unroll
        for (int nt = 0; nt < 2; ++nt) *(uint2*)(ST + (nt * 16 + fr) * 136 + (2 * wid + m2) * 16 + fq * 4) = pack4(Sacc[m2][nt]);
    __syncthreads();
    constexpr int K2 = TK / 32;
    auto ldf = [&](int n, bf16x8 (&kf)[2][K2], bf16x8 (&wf)[4], bf16x8 (&qf)[4], bf16x8 (&af)[K2], u32x2 (&uu)[2], float& egl) {
        const size_t it = (size_t)n * cstride;
        const bf16_t* W = W0 + it * (R * 128); const bf16_t* UT = UT0 + it * (128 * R); const bf16_t* QD = QD0 + it * (R * 128);
        const bf16_t* KDT = KDT0 + it * (128 * TK); const bf16_t* AQK = AQK0 + it * (R * TK);
        egl = EGL0[it];
        if (wid < MT) {
#pragma unroll
            for (int k4 = 0; k4 < 4; ++k4) wf[k4] = ld8(W + (wid * 16 + fr) * 128 + k4 * 32 + fq * 8);
#pragma unroll
            for (int nt = 0; nt < 2; ++nt) uu[nt] = *(const u32x2*)(UT + (s * 32 + nt * 16 + fr) * R + wid * 16 + fq * 4);
        }
#pragma unroll
        for (int m2 = 0; m2 < 2; ++m2)
#pragma unroll
            for (int k2 = 0; k2 < K2; ++k2) kf[m2][k2] = ld8(KDT + ((2 * wid + m2) * 16 + fr) * TK + k2 * 32 + fq * 8);
        if (wid < MT) {
#pragma unroll
            for (int k4 = 0; k4 < 4; ++k4) qf[k4] = ld8(QD + (wid * 16 + fr) * 128 + k4 * 32 + fq * 8);
#pragma unroll
            for (int k2 = 0; k2 < K2; ++k2) af[k2] = ld8(AQK + (wid * 16 + fr) * TK + k2 * 32 + fq * 8);
        }
    };
    auto flush_o = [&](int n) {
        const int t = tid >> 2, sg = tid & 3;
        if (t < nvalid) *(u32x4*)(obase + (size_t)(n * 64 + t) * 768 + sg * 8) = *(const u32x4*)(OT + t * 40 + sg * 8);
    };
    auto comp = [&](int n, const bf16x8 (&kf)[2][K2], const bf16x8 (&wf)[4], const bf16x8 (&qf)[4], const bf16x8 (&af)[K2], const u32x2 (&uu)[2], float egl) {
        f32x4 oacc[2];
        if (wid < MT) {
            bf16x8 sf[2][4];
#pragma unroll
            for (int nt = 0; nt < 2; ++nt)
#pragma unroll
                for (int k4 = 0; k4 < 4; ++k4) sf[nt][k4] = ld8(ST + (nt * 16 + fr) * 136 + k4 * 32 + fq * 8);
#pragma unroll
            for (int nt = 0; nt < 2; ++nt) {
                f32x4 vacc = (f32x4){0.f, 0.f, 0.f, 0.f};
#pragma unroll
                for (int k4 = 0; k4 < 4; ++k4) vacc = mfma16(wf[k4], sf[nt][k4], vacc);
                f32x4 vn;
                vn[0] = bflo(uu[nt][0]) - vacc[0]; vn[1] = bfhi(uu[nt][0]) - vacc[1]; vn[2] = bflo(uu[nt][1]) - vacc[2]; vn[3] = bfhi(uu[nt][1]) - vacc[3];
                *(uint2*)(VN + (nt * 16 + fr) * VLD + wid * 16 + fq * 4) = pack4(vn);
            }
#pragma unroll
            for (int nt = 0; nt < 2; ++nt) {
                oacc[nt] = (f32x4){0.f, 0.f, 0.f, 0.f};
#pragma unroll
                for (int k4 = 0; k4 < 4; ++k4) oacc[nt] = mfma16(qf[k4], sf[nt][k4], oacc[nt]);
            }
        }
        __syncthreads();
        if (n > 0) flush_o(n - 1);
        bf16x8 vf[2][K2];
#pragma unroll
        for (int nt = 0; nt < 2; ++nt)
#pragma unroll
            for (int k2 = 0; k2 < K2; ++k2) vf[nt][k2] = ld8(VN + (nt * 16 + fr) * VLD + k2 * 32 + fq * 8);
#pragma unroll
        for (int m2 = 0; m2 < 2; ++m2)
#pragma unroll
            for (int nt = 0; nt < 2; ++nt) {
                f32x4 a = Sacc[m2][nt] * egl;
#pragma unroll
                for (int k2 = 0; k2 < K2; ++k2) a = mfma16(kf[m2][k2], vf[nt][k2], a);
                Sacc[m2][nt] = a;
                *(uint2*)(ST + (nt * 16 + fr) * 136 + (2 * wid + m2) * 16 + fq * 4) = pack4(a);
            }
        __syncthreads();
        if (wid < MT) {
#pragma unroll
            for (int nt = 0; nt < 2; ++nt) {
#pragma unroll
                for (int k2 = 0; k2 < K2; ++k2) oacc[nt] = mfma16(af[k2], vf[nt][k2], oacc[nt]);
#pragma unroll
                for (int j = 0; j < 4; ++j) OT[(wid * 16 + fq * 4 + j) * 40 + nt * 16 + fr] = f2bf(oacc[nt][j]);
            }
        }
    };
    {
        bf16x8 kfA[2][K2], wfA[4], qfA[4], afA[K2]; u32x2 uuA[2]; float eglA;
        bf16x8 kfB[2][K2], wfB[4], qfB[4], afB[K2]; u32x2 uuB[2]; float eglB;
        ldf(0, kfA, wfA, qfA, afA, uuA, eglA);
        for (int n = 0; n < nchunks; n += 2) {
            ldf(n + 1 < nchunks ? n + 1 : nchunks - 1, kfB, wfB, qfB, afB, uuB, eglB);
            comp(n, kfA, wfA, qfA, afA, uuA, eglA);
            if (n + 1 < nchunks) {
                ldf(n + 2 < nchunks ? n + 2 : nchunks - 1, kfA, wfA, qfA, afA, uuA, eglA);
                comp(n + 1, kfB, wfB, qfB, afB, uuB, eglB);
            }
        }
        __syncthreads();
        flush_o(nchunks - 1);
    }
#pragma unroll
    for (int m2 = 0; m2 < 2; ++m2)
#pragma unroll
        for (int nt = 0; nt < 2; ++nt)
#pragma unroll
            for (int j = 0; j < 4; ++j) Sout[((2 * wid + m2) * 16 + fq * 4 + j) * 128 + s * 32 + nt * 16 + fr] = Sacc[m2][nt][j];
}

DEV void phase_gemm0(const Params& p, unsigned char* smem) {
    EpiA ea{(const float*)(p.ws + WS_RSQ), (bf16_t*)(p.ws + WS_PROJ), (float*)(p.ws + WS_BETA), (float*)(p.ws + WS_G), p.in[I_ALOG], p.in[I_DTB], p.out + O_GCP, p.out + O_GCS};
    EpiA2 ea2{(const float*)(p.ws + WS_RSQ), (bf16_t*)(p.ws + WS_PROJ), p.out + O_GCP, p.out + O_GCS};
    EpiM em{(const float*)(p.ws + WS_RSQM), p.out + O_MK, p.out + O_MV, (bf16_t*)(p.ws + WS_KB), (bf16_t*)(p.ws + WS_VB)};
    for (int t = blockIdx.x; t < 128 + 136 + 136 * 28; t += gridDim.x) {
        if (t < 128) gemm_tile<4>((const bf16_t*)(p.ws + WS_MEMB), (const bf16_t*)(p.ws + WS_WTM), (t >> 3) * 128, (t & 7) * 128, smem, em);
        else if (t < 264) gemm_tile<4>((const bf16_t*)(p.ws + WS_XB), (const bf16_t*)(p.ws + WS_WTA), (t - 128) * 128, 28 * 128, smem, ea);
        else { const int u = t - 264; gemm_tile<4, true>((const bf16_t*)(p.ws + WS_XB), (const bf16_t*)(p.ws + WS_WTA), (u / 28) * 128, (u % 28) * 128, smem, ea2); }
    }
}

DEV void phase_gdnprep_attn(const Params& p, unsigned char* smem, int* sh, int slot = 0) {
    unsigned* cnt = (unsigned*)(p.ws + WS_CNT) + slot;
    unsigned char* yb = (unsigned char*)p.out;
    for (;;) {
        const int slot = next_item(cnt, sh);
        if (slot >= 1536 + 768 + 1024) break;
        int it;
        if (slot < 2048) { const int g = slot >> 2, r = slot & 3; it = (r < 3) ? g * 3 + r : 2304 + 512 + g; }
        else if (slot < 2816) it = 1536 + (slot - 2048);
        else it = 2304 + (slot - 2816);
        if (it < 1536) {
            const int h = it % 6, bn = it / 6, b = bn >> 5, n = bn & 31;
            gdn_prep<64, 64, 64>(p, b * 2048 + n * 64, n * 64, -1, h,
                                 (bf16_t*)(yb + Y_WP) + (size_t)it * 8192, (bf16_t*)(yb + Y_UTP) + (size_t)it * 8192, (bf16_t*)(p.ws + WS_QDP) + (size_t)it * 8192,
                                 (bf16_t*)(p.ws + WS_KDTP) + (size_t)it * 8192, (bf16_t*)(p.ws + WS_AQKP) + (size_t)it * 4096, (float*)(p.ws + WS_EGLP) + it, smem);
        } else if (it < 2304) {
            const int i2 = it - 1536, h = i2 % 6, b = i2 / 6;
            gdn_prep<8, 16, 32>(p, NTOK_P + b * 8, 0, b, h,
                                (bf16_t*)(yb + Y_WS) + (size_t)i2 * 2048, (bf16_t*)(yb + Y_UTS) + (size_t)i2 * 2048, (bf16_t*)(yb + Y_QDS) + (size_t)i2 * 2048,
                                (bf16_t*)(yb + Y_KDTS) + (size_t)i2 * 4096, (bf16_t*)(yb + Y_AQKS) + (size_t)i2 * 512, (float*)(p.ws + WS_EGLS) + i2, smem);
        } else attn_item(p, 0, it - 2304, smem);
    }
}

DEV void scan_prompt_item(const Params& p, int q, int s, unsigned char* smem) {
    unsigned char* yb = (unsigned char*)p.out;
    bf16_t* OB = (bf16_t*)(p.ws + WS_XB);
    const int h = q % 6, b = q / 6;
    const size_t i0 = (size_t)(b * 32) * 6 + h;
    gdn_scan<4, 64, 64>(32, 6, (const bf16_t*)(yb + Y_WP) + i0 * 8192, (const bf16_t*)(yb + Y_UTP) + i0 * 8192, (const bf16_t*)(p.ws + WS_QDP) + i0 * 8192,
                        (const bf16_t*)(p.ws + WS_KDTP) + i0 * 8192, (const bf16_t*)(p.ws + WS_AQKP) + i0 * 4096, (const float*)(p.ws + WS_EGLP) + i0,
                        nullptr, p.out + O_SP + (size_t)(b * 6 + h) * 16384, OB + (size_t)(b * 2048) * 768 + h * 128 + s * 32, 64, s, smem);
}
DEV void late_wtile(const Params& p, int t, unsigned char* smem) {
    bf16_t* WtB = (bf16_t*)(p.ws + WS_WTB); bf16_t* WtO = (bf16_t*)(p.ws + WS_WTO);
    if (t < 896) prep_wtile(p.in[I_WB], 3584, p.in[I_NG] + 1024, WtB, (t >> 4) * 64, (t & 15) * 64, 0, smem);
    else { t -= 896; const int l = t >> 8, tt = t & 255; prep_wtile(p.in[I_WO] + (size_t)l * 1024 * 1024, 1024, nullptr, WtO + (size_t)l * 1024 * 1024, (tt >> 4) * 64, (tt & 15) * 64, 0, smem); }
}
DEV void phase_scan(const Params& p, unsigned char* smem, int* sh, int slot = 1) {
    unsigned* cnt = (unsigned*)(p.ws + WS_CNT) + slot;
    unsigned char* yb = (unsigned char*)p.out;
    bf16_t* OB = (bf16_t*)(p.ws + WS_XB);
    if (gridDim.x >= 192) {
        if (blockIdx.x < 192) { const int x = blockIdx.x & 7, j = blockIdx.x >> 3; scan_prompt_item(p, (j >> 2) * 8 + x, j & 3, smem); }
    } else {
        for (int it = blockIdx.x; it < 192; it += gridDim.x) scan_prompt_item(p, it >> 2, it & 3, smem);
    }
    for (;;) {
        const int i3 = next_item(cnt, sh);
        if (i3 >= 3072 + 1408) break;
        if (i3 >= 3072) { late_wtile(p, i3 - 3072, smem); continue; }
        const int s = i3 & 3, i2 = i3 >> 2, h = i2 % 6, b = i2 / 6;
        gdn_scan<1, 16, 32>(1, 0, (const bf16_t*)(yb + Y_WS) + (size_t)i2 * 2048, (const bf16_t*)(yb + Y_UTS) + (size_t)i2 * 2048, (const bf16_t*)(yb + Y_QDS) + (size_t)i2 * 2048,
                            (const bf16_t*)(yb + Y_KDTS) + (size_t)i2 * 4096, (const bf16_t*)(yb + Y_AQKS) + (size_t)i2 * 512, (const float*)(p.ws + WS_EGLS) + i2,
                            p.in[I_SG] + (size_t)i2 * 16384, p.out + O_SS + (size_t)i2 * 16384, OB + (size_t)(NTOK_P + b * 8) * 768 + h * 128 + s * 32, 8, s, smem);
    }
}

DEV void phase_gate0(const Params& p) {
    const int tid_ = tidx(); const int lane = tid_ & 63, wid = tid_ >> 6;
    const bf16_t* OB = (const bf16_t*)(p.ws + WS_XB);
    const bf16_t* proj = (const bf16_t*)(p.ws + WS_PROJ);
    bf16_t* br = (bf16_t*)(p.ws + WS_BR);
    const float2 g = *(const float2*)(p.in[I_ONG] + 2 * lane);
    for (int row = blockIdx.x * 4 + wid; row < NTOK; row += gridDim.x * 4) {
        unsigned uo[6], ug[6];
#pragma unroll
        for (int h = 0; h < 6; ++h) {
            uo[h] = *(const unsigned*)(OB + (size_t)row * 768 + h * 128 + 2 * lane);
            ug[h] = *(const unsigned*)(proj + (size_t)row * PROJ_LD + C_GATE + h * 128 + 2 * lane);
        }
        unsigned res[6];
#pragma unroll
        for (int h = 0; h < 6; ++h) {
            const float a = bflo(uo[h]), b = bfhi(uo[h]);
            const float ss = wave_sum(a * a + b * b);
            const float r = rsqrtf(ss * (1.f / 128.f) + 1e-6f);
            res[h] = pack2(a * r * g.x * silu_f(bflo(ug[h])), b * r * g.y * silu_f(bfhi(ug[h])));
        }
#pragma unroll
        for (int h = 0; h < 6; ++h) *(unsigned*)(br + (size_t)row * 1024 + h * 128 + 2 * lane) = res[h];
    }
}

DEV void phase_gemm_out(const Params& p, int layer, unsigned char* smem) {
    const bf16_t* A = (const bf16_t*)(p.ws + WS_BR); const bf16_t* Bt = (const bf16_t*)(p.ws + WS_WTO) + (size_t)layer * 1024 * 1024;
    const int G = gridDim.x, NTILES = 136 * 8, full = (NTILES / G) * G, rem = NTILES - full;
    auto mk = [&](int n0) { return EpiO{layer == 0 ? p.in[I_XP] : nullptr, layer == 0 ? p.in[I_XS] : nullptr, (bf16_t*)(p.ws + WS_XB), (float*)(p.ws + WS_PART), n0}; };
    for (int t = blockIdx.x; t < full; t += G) { const int n0 = (t & 7) * 128; gemm_tile<4>(A, Bt, (t >> 3) * 128, n0, smem, mk(n0)); }
    if (rem * 4 <= G) {
        for (int hh = blockIdx.x; hh < rem * 4; hh += G) { const int t = full + (hh >> 2), n0 = (t & 7) * 128; gemm_tile<1>(A, Bt, (t >> 3) * 128 + (hh & 3) * 32, n0, smem, mk(n0)); }
    } else if (rem * 2 <= G) {
        for (int hh = blockIdx.x; hh < rem * 2; hh += G) { const int t = full + (hh >> 1), n0 = (t & 7) * 128; gemm_tile<2>(A, Bt, (t >> 3) * 128 + (hh & 1) * 64, n0, smem, mk(n0)); }
    } else {
        for (int t = full + blockIdx.x; t < NTILES; t += G) { const int n0 = (t & 7) * 128; gemm_tile<4>(A, Bt, (t >> 3) * 128, n0, smem, mk(n0)); }
    }
}

DEV void phase_gemm1(const Params& p, unsigned char* smem) {
    EpiB2 eb{(const float*)(p.ws + WS_PART), (bf16_t*)(p.ws + WS_PROJ)};
    const bf16_t* A = (const bf16_t*)(p.ws + WS_XB); const bf16_t* Bt = (const bf16_t*)(p.ws + WS_WTB);
    const int G = gridDim.x, NTILES = 136 * 28, full = (NTILES / G) * G, rem = NTILES - full;
    for (int t = blockIdx.x; t < full; t += G) gemm_tile<4, true>(A, Bt, (t / 28) * 128, (t % 28) * 128, smem, eb);
    if (rem * 2 <= G) {
        for (int hh = blockIdx.x; hh < rem * 2; hh += G) { const int t = full + (hh >> 1); gemm_tile<2, true>(A, Bt, (t / 28) * 128 + (hh & 1) * 64, (t % 28) * 128, smem, eb); }
    } else {
        for (int t = full + blockIdx.x; t < NTILES; t += G) gemm_tile<4, true>(A, Bt, (t / 28) * 128, (t % 28) * 128, smem, eb);
    }
}

DEV void sconv_rows(const Params& p, int blk) {
    const int tid_ = tidx(); const int lane = tid_ & 63, wid = tid_ >> 6;
    const int row = blk * 4 + wid;
    const bf16_t* proj = (const bf16_t*)(p.ws + WS_PROJ);
    bf16_t* br = (bf16_t*)(p.ws + WS_BR);
    const float* cw = p.in[I_CWB];
    int t, L, b; size_t seqrow0;
    if (row < NTOK_P) { b = row >> 11; t = row & 2047; L = 2048; seqrow0 = (size_t)b * 2048; }
    else { const int rs = row - NTOK_P; b = rs >> 3; t = rs & 7; L = 8; seqrow0 = NTOK_P + (size_t)b * 8; }
    f32x4 ov[3], ul[3];
#pragma unroll
    for (int i = 0; i < 3; ++i) {
        const int c = i * 256 + lane * 4;
        f32x4 u[3];
#pragma unroll
        for (int j = 0; j < 3; ++j) {
            const int ts = t - 2 + j;
            if (ts >= 0) {
                const bf16_t* pr = proj + (seqrow0 + ts) * PROJ_LD;
                const uint2 cg = *(const uint2*)(pr + 768 + c), xs = *(const uint2*)(pr + 1536 + c);
                u[j][0] = bflo(cg.x) * bflo(xs.x); u[j][1] = bfhi(cg.x) * bfhi(xs.x); u[j][2] = bflo(cg.y) * bflo(xs.y); u[j][3] = bfhi(cg.y) * bfhi(xs.y);
            } else if (row >= NTOK_P) u[j] = *(const f32x4*)(p.in[I_SSC] + (size_t)(b * 2 + 2 + ts) * 768 + c);
            else u[j] = (f32x4){0.f, 0.f, 0.f, 0.f};
        }
        const f32x4 w0 = *(const f32x4*)(cw + c), w1 = *(const f32x4*)(cw + 768 + c), w2 = *(const f32x4*)(cw + 1536 + c);
        const f32x4 y = w0 * u[0] + w1 * u[1] + w2 * u[2];
        const bf16_t* pr = proj + (size_t)row * PROJ_LD;
        const uint2 bg = *(const uint2*)(pr + c), gt = *(const uint2*)(pr + C_GATE + c);
        ov[i][0] = bflo(bg.x) * y[0] * silu_f(bflo(gt.x)); ov[i][1] = bfhi(bg.x) * y[1] * silu_f(bfhi(gt.x));
        ov[i][2] = bflo(bg.y) * y[2] * silu_f(bflo(gt.y)); ov[i][3] = bfhi(bg.y) * y[3] * silu_f(bfhi(gt.y));
        ul[i] = u[2];
    }
#pragma unroll
    for (int i = 0; i < 3; ++i) {
        const int c = i * 256 + lane * 4;
        *(uint2*)(br + (size_t)row * 1024 + c) = pack4(ov[i]);
        if (t >= L - 2) {
            float* dst = (row < NTOK_P ? p.out + O_SCP : p.out + O_SCS) + (size_t)(b * 2 + (t - (L - 2))) * 768 + c;
            *(f32x4*)dst = ul[i];
        }
    }
}
DEV void phase_sconv_attn(const Params& p, unsigned char* smem, int* sh, int slot = 2) {
    unsigned* cnt = (unsigned*)(p.ws + WS_CNT) + slot;
    for (;;) {
        const int it = next_item(cnt, sh);
        if (it >= 1024 + NTOK / 4) break;
        if (it < 1024) attn_item(p, 1, it, smem);
        else sconv_rows(p, it - 1024);
    }
}

DEV void phase_final(const Params& p) {
    const int tid_ = tidx(); const int lane = tid_ & 63, wid = tid_ >> 6;
    const float* part = (const float*)(p.ws + WS_PART);
    const bf16_t* xb = (const bf16_t*)(p.ws + WS_XB);
    const float* g = p.in[I_FNG];
    float* y = p.out + O_Y;
    for (int row = blockIdx.x * 4 + wid; row < NTOK; row += gridDim.x * 4) {
        float ss = (lane < 16) ? part[row * 16 + lane] : 0.f;
        ss = wave_sum(ss);
        const float r = rsqrtf(ss * (1.f / 1024.f) + 1e-6f);
#pragma unroll
        for (int i = 0; i < 4; ++i) {
            const uint2 u = ((const uint2*)(xb + (size_t)row * 1024))[i * 64 + lane];
            const f32x4 gg = ((const f32x4*)g)[i * 64 + lane];
            f32x4 v = {bflo(u.x), bfhi(u.x), bflo(u.y), bfhi(u.y)};
            ((f32x4*)(y + (size_t)row * 1024))[i * 64 + lane] = v * r * gg;
        }
    }
}

DEV void run_phase(const Params& p, int ph, unsigned char* smem, int* sh) {
    switch (ph) {
    case 0: phase_prep(p, smem); break;
    case 1: phase_gemm0(p, smem); break;
    case 2: phase_gdnprep_attn(p, smem, sh); break;
    case 3: phase_scan(p, smem, sh); break;
    case 4: phase_gate0(p); break;
    case 5: phase_gemm_out(p, 0, smem); break;
    case 6: phase_gemm1(p, smem); break;
    case 7: phase_sconv_attn(p, smem, sh); break;
    case 8: phase_gemm_out(p, 1, smem); break;
    default: phase_final(p); break;
    }
}

extern __shared__ __attribute__((aligned(16))) unsigned char dyn_smem[];

#if !defined(ONLY) && !MULTI
__global__ void __launch_bounds__(256, 2) k_mega(Params p) {
    __shared__ int sh_item[4];
    cg::grid_group grid = cg::this_grid();
    __shared__ uint4 xb_words;
    if (threadIdx.x == 0) xb_words = make_uint4(0u, 0u, 0u, 0u);
    __syncthreads();
    XcdBarrier xb = xcd_barrier_post((unsigned*)(p.ws + WS_XBAR), (volatile LAS unsigned*)&xb_words);
    if (p.ws == nullptr) grid.sync();
    phase_prep(p, dyn_smem); xcd_barrier(xb);
    phase_gemm0(p, dyn_smem); xcd_barrier(xb);
    phase_gdnprep_attn(p, dyn_smem, sh_item); xcd_barrier(xb);
    phase_scan(p, dyn_smem, sh_item); xcd_barrier(xb);
    phase_gate0(p); xcd_barrier(xb);
    phase_gemm_out(p, 0, dyn_smem); xcd_barrier(xb);
    phase_gemm1(p, dyn_smem); xcd_barrier(xb);
    phase_sconv_attn(p, dyn_smem, sh_item); xcd_barrier(xb);
    phase_gemm_out(p, 1, dyn_smem); xcd_barrier(xb);
    phase_final(p);
}

#endif
__global__ void __launch_bounds__(256, 2) k_phase(Params p, int ph) {
    __shared__ int sh_item[4];
#ifdef ONLY
    run_phase(p, ONLY, dyn_smem, sh_item);
#else
    run_phase(p, ph, dyn_smem, sh_item);
#endif
}

extern "C" void kernel_launch(void* const* d_in, const int* in_sizes, int n_in, void* d_out, int out_size, void* d_ws, size_t ws_size, hipStream_t stream) {
    static int grid_blocks = 0;
    if (!grid_blocks) {
        if (n_in != 20 || ws_size < WS_END) { fprintf(stderr, "kernel_launch: unexpected n_in %d / ws_size %zu (need %zu)\n", n_in, ws_size, (size_t)WS_END); grid_blocks = -1; return; }
        int dev = 0, cus = 0, per_cu = 0;
        (void)hipGetDevice(&dev);
        (void)hipDeviceGetAttribute(&cus, hipDeviceAttributeMultiprocessorCount, dev);
#if MULTI
        (void)hipFuncSetAttribute((const void*)k_phase, hipFuncAttributeMaxDynamicSharedMemorySize, LDS_BYTES);
        (void)hipOccupancyMaxActiveBlocksPerMultiprocessor(&per_cu, (const void*)k_phase, 256, LDS_BYTES);
#else
        (void)hipFuncSetAttribute((const void*)k_mega, hipFuncAttributeMaxDynamicSharedMemorySize, LDS_BYTES);
        (void)hipOccupancyMaxActiveBlocksPerMultiprocessor(&per_cu, (const void*)k_mega, 256, LDS_BYTES);
#endif
        if (per_cu < 1) per_cu = 1;
        if (per_cu > 2) per_cu = 2;
        grid_blocks = cus * per_cu;
        (void)hipGetLastError();
    }
    if (grid_blocks < 0) return;
    Params p{};
    for (int i = 0; i < 20; ++i) p.in[i] = (const float*)d_in[i];
    p.out = (float*)d_out; p.ws = (unsigned char*)d_ws;
#ifdef CLEARALL
    (void)hipMemsetAsync(d_ws, 0, WS_END, stream);
    (void)hipMemsetAsync(d_out, 0, (size_t)out_size * 4, stream);
#endif
#if MULTI
    for (int ph = 0; ph < RUNPH; ++ph) hipLaunchKernelGGL(k_phase, dim3(grid_blocks), dim3(256), LDS_BYTES, stream, p, ph);
#ifdef CLEARALL
    if (RUNPH < 6) (void)hipMemsetAsync(d_out, 0, 17825792ull * 4, stream);
#endif
#else
    (void)hipMemsetAsync((unsigned char*)d_ws + WS_XBAR, 0, XCD_BAR_WORDS * 4, stream);
    void* args[] = {&p};
    hipError_t e = hipLaunchCooperativeKernel((const void*)k_mega, dim3(grid_blocks), dim3(256), args, LDS_BYTES, stream);
    if (e != hipSuccess) fprintf(stderr, "cooperative launch failed: %s (grid %d)\n", hipGetErrorString(e), grid_blocks);
#endif
}
```

```cpp
#include <hip/hip_runtime.h>
#include <hip/hip_cooperative_groups.h>
#include <cstdio>
namespace cg = cooperative_groups;

#ifndef MULTI
#define MULTI 0
#endif
#ifndef RUNPH
#define RUNPH 10
#endif

typedef unsigned short bf16_t;
typedef short bf16x8 __attribute__((ext_vector_type(8)));
typedef float f32x4 __attribute__((ext_vector_type(4)));
typedef unsigned u32x4 __attribute__((ext_vector_type(4)));
typedef unsigned u32x2 __attribute__((ext_vector_type(2)));
typedef float f32x2 __attribute__((ext_vector_type(2)));
#define DEV __device__ __forceinline__
DEV int tidx() { int t = threadIdx.x; asm volatile("" : "+v"(t)); return t; }

constexpr int NTOK_P = 16384, NTOK = 17408, NROWS_ALL = 19456;
constexpr int PROJ_LD = 3584, NPA = 3712;
constexpr int C_GATE = 2304, C_XQ = 3328;
constexpr int LDS_BYTES = 73728;
constexpr int NPHASE = 10;

constexpr size_t WS_WTA = 0;
constexpr size_t WS_WTB = WS_WTA + 3712ull * 1024 * 2;
constexpr size_t WS_WTO = WS_WTB + 3584ull * 1024 * 2;
constexpr size_t WS_WTM = WS_WTO + 2ull * 1024 * 1024 * 2;
constexpr size_t WS_XB = WS_WTM + 1024ull * 1024 * 2;
constexpr size_t WS_BR = WS_XB + 17408ull * 1024 * 2;
constexpr size_t WS_MEMB = WS_BR + 17408ull * 1024 * 2;
constexpr size_t WS_RSQ = WS_MEMB + 2048ull * 1024 * 2;
constexpr size_t WS_RSQM = WS_RSQ + 17408ull * 4;
constexpr size_t WS_PART = WS_RSQM + 2048ull * 4;
constexpr size_t WS_BETA = WS_PART + 17408ull * 16 * 4;
constexpr size_t WS_G = WS_BETA + 17408ull * 6 * 4;
constexpr size_t WS_KB = WS_G + 17408ull * 6 * 4;
constexpr size_t WS_VB = WS_KB + 2ull * 2048 * 256 * 2;
constexpr size_t WS_CNT = WS_VB + 2ull * 2048 * 256 * 2;
constexpr size_t WS_BAR = WS_CNT + 256;
constexpr size_t WS_XBAR = WS_BAR + 256;
constexpr size_t WS_EGLP = WS_XBAR + 16384;
constexpr size_t WS_EGLS = WS_EGLP + 1536 * 4;
constexpr size_t WS_PROJ = WS_EGLS + 768 * 4;
constexpr size_t WS_QDP = WS_PROJ + 17408ull * 3584 * 2;
constexpr size_t WS_KDTP = WS_QDP + 1536ull * 16384;
constexpr size_t WS_AQKP = WS_KDTP + 1536ull * 16384;
constexpr size_t WS_END = WS_AQKP + 1536ull * 8192;
constexpr size_t Y_WP = 0;
constexpr size_t Y_UTP = Y_WP + 1536ull * 16384;
constexpr size_t Y_WS = Y_UTP + 1536ull * 16384;
constexpr size_t Y_UTS = Y_WS + 768ull * 4096;
constexpr size_t Y_QDS = Y_UTS + 768ull * 4096;
constexpr size_t Y_KDTS = Y_QDS + 768ull * 4096;
constexpr size_t Y_AQKS = Y_KDTS + 768ull * 8192;
constexpr size_t O_Y = 0, O_SP = 17825792, O_GCP = 18612224, O_SCP = 18667520, O_MK = 18679808, O_MV = 19728384,
                 O_SS = 20776960, O_GCS = 33359872, O_SCS = 34244608;

struct Params {
    const float* in[20];
    float* out;
    unsigned char* ws;
};
enum { I_XP = 0, I_XS, I_MEM, I_SG, I_SGC, I_SSC, I_CK, I_CV, I_NG, I_WA, I_CWA, I_ALOG, I_DTB, I_ONG, I_WB, I_CWB, I_MNG, I_WM, I_WO, I_FNG };

typedef __bf16 bf16v2 __attribute__((ext_vector_type(2)));
DEV unsigned pack2(float lo, float hi) { const f32x2 v = {lo, hi}; return __builtin_bit_cast(unsigned, __builtin_convertvector(v, bf16v2)); }
DEV bf16_t f2bf(float f) { return (bf16_t)(pack2(f, 0.f) & 0xffffu); }
DEV float bf2f(bf16_t h) { return __uint_as_float(((unsigned)h) << 16); }
DEV float bflo(unsigned u) { return __uint_as_float(u << 16); }
DEV float bfhi(unsigned u) { return __uint_as_float(u & 0xffff0000u); }
DEV uint2 pack4(f32x4 v) { return make_uint2(pack2(v[0], v[1]), pack2(v[2], v[3])); }
DEV float silu_f(float x) { return x * __builtin_amdgcn_rcpf(1.f + __expf(-x)); }
DEV float wave_sum(float v) {
#pragma unroll
    for (int o = 32; o > 0; o >>= 1) v += __shfl_xor(v, o);
    return v;
}
DEV f32x4 mfma16(bf16x8 a, bf16x8 b, f32x4 c) { return __builtin_amdgcn_mfma_f32_16x16x32_bf16(a, b, c, 0, 0, 0); }
DEV bf16x8 ld8(const bf16_t* p) { return *reinterpret_cast<const bf16x8*>(p); }

#define XB_TMO      128
#define XB_XCNT(j)  (256  + 64 * (j))
#define XB_XSUB(j)  (1280 + 64 * (j))
#define XB_XGEN(j)  (2304 + 64 * (j))
#define XB_TOP      3328
#define XB_TOPGEN   3392
#define XCD_BAR_WORDS 3456
#define XB_SPIN_CAP (1u << 18)
#define LAS __attribute__((address_space(3)))

__device__ __forceinline__ unsigned xb_ld(unsigned* p)              { return __hip_atomic_load(p, __ATOMIC_RELAXED, __HIP_MEMORY_SCOPE_AGENT); }
__device__ __forceinline__ unsigned xb_add(unsigned* p, unsigned v) { return __hip_atomic_fetch_add(p, v, __ATOMIC_RELAXED, __HIP_MEMORY_SCOPE_AGENT); }
__device__ __forceinline__ unsigned xb_xcc_id() { return (unsigned)__builtin_amdgcn_s_getreg((3 << 11) | 20) & 0xFu; }
#define XB_SPIN(cond, bar) do { unsigned _sp = 0; while (cond) { __builtin_amdgcn_s_sleep(1); \
    if ((++_sp & 255u) == 0u) { if (xb_ld(&(bar)[XB_TMO])) break; if (_sp > XB_SPIN_CAP) { atomicAdd(&(bar)[XB_TMO], 1u); break; } } } } while (0)

struct XcdBarrier {
    unsigned* bar; unsigned x;
    volatile LAS unsigned* st;
};

__device__ __forceinline__ XcdBarrier xcd_barrier_post(unsigned* bar, volatile LAS unsigned* st) {
    XcdBarrier b; b.bar = bar; b.x = xb_xcc_id(); b.st = st;
    if (threadIdx.x == 0) (void)xb_add(&bar[XB_XCNT(b.x)], 1u);
    return b;
}
__device__ __forceinline__ void xcd_barrier_complete(unsigned* bar, unsigned x, unsigned& nloc, unsigned& nx) {
    const unsigned G = gridDim.x * gridDim.y * gridDim.z;
    unsigned sum, cnt, mine, sp = 0u;
    for (;;) {
        sum = 0u; cnt = 0u; mine = 0u;
#pragma unroll
        for (unsigned j = 0; j < 16; ++j) { const unsigned c = xb_ld(&bar[XB_XCNT(j)]); sum += c; cnt += (c > 0u) ? 1u : 0u; mine = (j == x) ? c : mine; }
        if (sum == G) break;
        __builtin_amdgcn_s_sleep(1);
        if ((++sp & 255u) == 0u) { if (xb_ld(&bar[XB_TMO])) break; if (sp > XB_SPIN_CAP) { atomicAdd(&bar[XB_TMO], 1u); break; } }
    }
    nloc = mine > 0u ? mine : 1u; nx = cnt > 0u ? cnt : 1u;
}

__device__ __forceinline__ void xcd_barrier(const XcdBarrier& b) {
    asm volatile("s_waitcnt vmcnt(0)" ::: "memory");
    __syncthreads();
    if (threadIdx.x == 0) {
        unsigned* bar = b.bar;
        __builtin_amdgcn_s_waitcnt(0);
        unsigned nloc = b.st[0], nx = b.st[1];
        if (nloc == 0u) { xcd_barrier_complete(bar, b.x, nloc, nx); b.st[0] = nloc; b.st[1] = nx; }
        const unsigned old = xb_add(&bar[XB_XSUB(b.x)], 1u);
        const unsigned gen = old / nloc;
        if (old + 1u == (gen + 1u) * nloc) {
            __builtin_amdgcn_fence(__ATOMIC_RELEASE, "agent");
            asm volatile("s_waitcnt vmcnt(0)" ::: "memory");
            const unsigned og = xb_add(&bar[XB_TOP], 1u);
            const unsigned tg = og / nx;
            if (og + 1u == (tg + 1u) * nx) xb_add(&bar[XB_TOPGEN], 1u);
            else XB_SPIN(xb_ld(&bar[XB_TOPGEN]) == tg, bar);
            __builtin_amdgcn_fence(__ATOMIC_ACQUIRE, "agent");
            xb_add(&bar[XB_XGEN(b.x)], 1u);
            asm volatile("s_waitcnt vmcnt(0)" ::: "memory");
        } else {
            XB_SPIN(xb_ld(&bar[XB_XGEN(b.x)]) == gen, bar);
            __builtin_amdgcn_fence(__ATOMIC_ACQUIRE, "agent");
            asm volatile("s_waitcnt vmcnt(0)" ::: "memory");
        }
    }
    __syncthreads();
}


DEV void grid_barrier(unsigned* bar, unsigned target) {
    asm volatile("s_waitcnt vmcnt(0) lgkmcnt(0)" ::: "memory");
    __syncthreads();
    if (threadIdx.x == 0) {
        __builtin_amdgcn_fence(__ATOMIC_RELEASE, "agent");
        asm volatile("s_waitcnt vmcnt(0)" ::: "memory");
        __hip_atomic_fetch_add(bar, 1u, __ATOMIC_RELAXED, __HIP_MEMORY_SCOPE_AGENT);
        while (__hip_atomic_load(bar, __ATOMIC_RELAXED, __HIP_MEMORY_SCOPE_AGENT) < target) __builtin_amdgcn_s_sleep(2);
        __builtin_amdgcn_fence(__ATOMIC_ACQUIRE, "agent");
        asm volatile("s_waitcnt vmcnt(0)" ::: "memory");
    }
    __syncthreads();
}

DEV int next_item(unsigned* cnt, int* sh) {
    __syncthreads();
    if (threadIdx.x == 0) *sh = (int)atomicAdd(cnt, 1u);
    __syncthreads();
    return *sh;
}

DEV void prep_wtile(const float* __restrict__ src, int ld, const float* __restrict__ g, bf16_t* __restrict__ dst, int n0, int k0, int mode, unsigned char* smem) {
    float* tile = (float*)smem;
    const int tid = tidx();
    {
        const int n = tid & 63;
        int nn = n0 + n, col = nn;
        if (mode == 1) { col = nn < 2304 ? nn : (nn < 3584 ? nn + 12 : (nn < 3596 ? nn - 1280 : -1)); }
        float v[16];
#pragma unroll
        for (int i = 0; i < 16; ++i) {
            const int k = i * 4 + (tid >> 6);
            v[i] = (col >= 0) ? src[(size_t)(k0 + k) * ld + col] : 0.f;
        }
#pragma unroll
        for (int i = 0; i < 16; ++i) {
            const int k = i * 4 + (tid >> 6);
            tile[k * 65 + n] = g ? v[i] * g[k0 + k] : v[i];
        }
    }
    __syncthreads();
    {
        const int n = tid >> 2, ks = tid & 3;
        unsigned w[8];
#pragma unroll
        for (int i = 0; i < 8; ++i) w[i] = pack2(tile[(ks * 16 + 2 * i) * 65 + n], tile[(ks * 16 + 2 * i + 1) * 65 + n]);
        uint4* d = (uint4*)(dst + (size_t)(n0 + n) * 1024 + k0 + ks * 16);
        d[0] = make_uint4(w[0], w[1], w[2], w[3]);
        d[1] = make_uint4(w[4], w[5], w[6], w[7]);
    }
    __syncthreads();
}

DEV void phase_prep(const Params& p, unsigned char* smem) {
    const int tid = tidx(), lane = tid & 63, wid = tid >> 6;
    if (blockIdx.x == 0 && tid < 64) ((unsigned*)(p.ws + WS_CNT))[tid] = 0u;
    bf16_t* WtA = (bf16_t*)(p.ws + WS_WTA); bf16_t* WtB = (bf16_t*)(p.ws + WS_WTB);
    bf16_t* WtO = (bf16_t*)(p.ws + WS_WTO); bf16_t* WtM = (bf16_t*)(p.ws + WS_WTM);
    const int NW = 928 + 256, NR = NROWS_ALL / 4;
    for (int it = blockIdx.x; it < NW + NR; it += gridDim.x) {
        if (it < NW) {
            int t = it;
            if (t < 928) { prep_wtile(p.in[I_WA], 3596, p.in[I_NG], WtA, (t >> 4) * 64, (t & 15) * 64, 1, smem); }
            else { t -= 928; int l = t >> 7, tt = t & 127; prep_wtile(p.in[I_WM] + (size_t)l * 1024 * 512, 512, p.in[I_MNG], WtM + (size_t)l * 512 * 1024, (tt >> 4) * 64, (tt & 15) * 64, 0, smem); }
        } else {
            const int row = (it - NW) * 4 + wid;
            const float* src; bf16_t* dst; float* rs;
            if (row < NTOK_P) { src = p.in[I_XP] + (size_t)row * 1024; dst = (bf16_t*)(p.ws + WS_XB) + (size_t)row * 1024; rs = (float*)(p.ws + WS_RSQ) + row; }
            else if (row < NTOK) { src = p.in[I_XS] + (size_t)(row - NTOK_P) * 1024; dst = (bf16_t*)(p.ws + WS_XB) + (size_t)row * 1024; rs = (float*)(p.ws + WS_RSQ) + row; }
            else { src = p.in[I_MEM] + (size_t)(row - NTOK) * 1024; dst = (bf16_t*)(p.ws + WS_MEMB) + (size_t)(row - NTOK) * 1024; rs = (float*)(p.ws + WS_RSQM) + (row - NTOK); }
            float4 v[4]; float ss = 0.f;
#pragma unroll
            for (int i = 0; i < 4; ++i) { v[i] = ((const float4*)src)[i * 64 + lane]; ss += v[i].x * v[i].x + v[i].y * v[i].y + v[i].z * v[i].z + v[i].w * v[i].w; }
            ss = wave_sum(ss);
            if (lane == 0) *rs = rsqrtf(ss * (1.f / 1024.f) + 1e-6f);
#pragma unroll
            for (int i = 0; i < 4; ++i) ((uint2*)dst)[i * 64 + lane] = make_uint2(pack2(v[i].x, v[i].y), pack2(v[i].z, v[i].w));
        }
    }
}

template <int MF = 4, bool STAGED = false, class Epi>
DEV void gemm_tile(const bf16_t* __restrict__ A, const bf16_t* __restrict__ Bt, int m0, int n0, unsigned char* smem, const Epi& epi) {
    const int tid = tidx(), lane = tid & 63, wid = tid >> 6, wr = wid >> 1, wc = wid & 1;
    const int fr = lane & 15, fq = lane >> 4;
    bf16_t* As = (bf16_t*)smem;
    bf16_t* Bs = As + 2 * 128 * 64;
    f32x4 acc[MF][4];
#pragma unroll
    for (int m = 0; m < MF; ++m)
#pragma unroll
        for (int n = 0; n < 4; ++n) acc[m][n] = (f32x4){0.f, 0.f, 0.f, 0.f};
    const int lrow = tid >> 3, lseg = tid & 7;
    const bf16_t* Ag = A + (size_t)(m0 + lrow) * 1024 + lseg * 8;
    const bf16_t* Bg = Bt + (size_t)(n0 + lrow) * 1024 + lseg * 8;
    typedef __attribute__((address_space(3))) void* lds_ptr_t;
    const int gch = (lseg ^ (lrow & 7)) * 8;
    auto stage = [&](int kt, int buf) {
        bf16_t* An = As + buf * 128 * 64; bf16_t* Bn = Bs + buf * 128 * 64;
#pragma unroll
        for (int i = 0; i < 4; ++i) {
            if (i < MF) __builtin_amdgcn_global_load_lds((const unsigned*)(Ag - lseg * 8 + gch + (size_t)i * 32 * 1024 + kt * 64), (lds_ptr_t)(An + (lrow + i * 32) * 64 + lseg * 8), 16, 0, 0);
            __builtin_amdgcn_global_load_lds((const unsigned*)(Bg - lseg * 8 + gch + (size_t)i * 32 * 1024 + kt * 64), (lds_ptr_t)(Bn + (lrow + i * 32) * 64 + lseg * 8), 16, 0, 0);
        }
    };
    auto compute = [&](int buf) {
        const bf16_t* Ac = As + buf * 128 * 64 + (wr * (MF * 16) + fr) * 64;
        const bf16_t* Bc = Bs + buf * 128 * 64 + (wc * 64 + fr) * 64;
#pragma unroll
        for (int ks = 0; ks < 2; ++ks) {
            bf16x8 af[MF], bfv[4];
            const int co = ((ks * 4 + fq) ^ (fr & 7)) * 8;
#pragma unroll
            for (int m = 0; m < MF; ++m) af[m] = ld8(Ac + m * 16 * 64 + co);
#pragma unroll
            for (int n = 0; n < 4; ++n) bfv[n] = ld8(Bc + n * 16 * 64 + co);
#pragma unroll
            for (int m = 0; m < MF; ++m)
#pragma unroll
                for (int n = 0; n < 4; ++n) acc[m][n] = mfma16(bfv[n], af[m], acc[m][n]);
        }
    };
    __syncthreads();
    stage(0, 0);
#pragma unroll 1
    for (int kt = 0; kt < 16; ++kt) {
        const int cur = kt & 1;
        asm volatile("s_waitcnt vmcnt(0)" ::: "memory");
        __syncthreads();
        if (kt + 1 < 16) stage(kt + 1, cur ^ 1);
        compute(cur);
    }
    if constexpr (STAGED) {
        bf16_t* Cs = (bf16_t*)smem;
        __syncthreads();
#pragma unroll
        for (int m = 0; m < MF; ++m) {
            const int rl = wr * (MF * 16) + m * 16 + fr;
            const float sc = epi.scale(m0 + rl);
#pragma unroll
            for (int n = 0; n < 4; ++n) {
                const f32x4 v = acc[m][n] * sc;
                epi.special(m0 + rl, n0 + wc * 64 + n * 16 + fq * 4, v);
                *(uint2*)(Cs + rl * 136 + wc * 64 + n * 16 + fq * 4) = pack4(v);
            }
        }
        __syncthreads();
#pragma unroll
        for (int i = 0; i < MF * 2; ++i) {
            const int idx = i * 256 + tid, rl = idx >> 4, ch = idx & 15;
            epi.store(m0 + rl, n0 + ch * 8, *(const u32x4*)(Cs + rl * 136 + ch * 8));
        }
    } else {
#pragma unroll
        for (int m = 0; m < MF; ++m) epi(m0 + wr * (MF * 16) + m * 16 + fr, n0 + wc * 64 + fq * 4, acc[m]);
    }
}

struct EpiA {
    const float* rsq; bf16_t* proj; float* beta; float* gbuf; const float* a_log; const float* dt_bias; float* gcp; float* gcs;
    DEV void operator()(int row, int col0, const f32x4 (&acc)[4]) const {
        const float r = rsq[row];
#pragma unroll
        for (int n = 0; n < 4; ++n) {
            const int col = col0 + n * 16;
            f32x4 v = acc[n] * r;
            if (col < PROJ_LD) {
                *(uint2*)(proj + (size_t)row * PROJ_LD + col) = pack4(v);
                if (col < 2304) {
                    if (row < NTOK_P) { const int t = row & 2047; if (t >= 2045) *(f32x4*)(gcp + (size_t)((row >> 11) * 3 + (t - 2045)) * 2304 + col) = v; }
                    else { const int rs = row - NTOK_P, t = rs & 7; if (t >= 5) *(f32x4*)(gcs + (size_t)((rs >> 3) * 3 + (t - 5)) * 2304 + col) = v; }
                }
            } else {
#pragma unroll
                for (int j = 0; j < 4; ++j) {
                    const int cc = col - PROJ_LD + j;
                    if (cc < 6) beta[row * 6 + cc] = 1.f / (1.f + expf(-v[j]));
                    else if (cc < 12) { const int h = cc - 6; const float z = v[j] + dt_bias[h]; const float sp = z > 20.f ? z : log1pf(expf(z)); gbuf[row * 6 + h] = -expf(a_log[h]) * sp; }
                }
            }
        }
    }
};
struct EpiA2 {
    const float* rsq; bf16_t* proj; float* gcp; float* gcs;
    DEV float scale(int row) const { return rsq[row]; }
    DEV void special(int row, int col, f32x4 v) const {
        if (col < 2304) {
            if (row < NTOK_P) { const int t = row & 2047; if (t >= 2045) *(f32x4*)(gcp + (size_t)((row >> 11) * 3 + (t - 2045)) * 2304 + col) = v; }
            else { const int rs = row - NTOK_P, t = rs & 7; if (t >= 5) *(f32x4*)(gcs + (size_t)((rs >> 3) * 3 + (t - 5)) * 2304 + col) = v; }
        }
    }
    DEV void store(int row, int col, u32x4 c) const { *(u32x4*)(proj + (size_t)row * PROJ_LD + col) = c; }
};
struct EpiB2 {
    const float* part; bf16_t* proj;
    DEV float scale(int row) const {
        float ss = 0.f;
#pragma unroll
        for (int i = 0; i < 4; ++i) { const f32x4 q = *(const f32x4*)(part + row * 16 + i * 4); ss += q[0] + q[1] + q[2] + q[3]; }
        return rsqrtf(ss * (1.f / 1024.f) + 1e-6f);
    }
    DEV void special(int, int, f32x4) const {}
    DEV void store(int row, int col, u32x4 c) const { *(u32x4*)(proj + (size_t)row * PROJ_LD + col) = c; }
};
struct EpiM {
    const float* rsq; float* mk; float* mv; bf16_t* kb; bf16_t* vb;
    DEV void operator()(int row, int col0, const f32x4 (&acc)[4]) const {
        const float r = rsq[row];
#pragma unroll
        for (int n = 0; n < 4; ++n) {
            const int col = col0 + n * 16, l = col >> 9, e = col & 511, e2 = e & 255;
            f32x4 v = acc[n] * r;
            const size_t idx = ((size_t)l * 2048 + row) * 256 + e2;
            if (e < 256) { *(f32x4*)(mk + idx) = v; *(uint2*)(kb + idx) = pack4(v); }
            else { *(f32x4*)(mv + idx) = v; *(uint2*)(vb + idx) = pack4(v); }
        }
    }
};
struct EpiO {
    const float* xp; const float* xs; bf16_t* xb; float* part; int n0;
    DEV void operator()(int row, int col0, const f32x4 (&acc)[4]) const {
        float ss = 0.f;
#pragma unroll
        for (int n = 0; n < 4; ++n) {
            const int col = col0 + n * 16;
            f32x4 v;
            if (xp) {
                const float* xr = row < NTOK_P ? xp + (size_t)row * 1024 : xs + (size_t)(row - NTOK_P) * 1024;
                v = acc[n] + *(const f32x4*)(xr + col);
            } else {
                const uint2 u = *(const uint2*)(xb + (size_t)row * 1024 + col);
                v[0] = acc[n][0] + bflo(u.x); v[1] = acc[n][1] + bfhi(u.x); v[2] = acc[n][2] + bflo(u.y); v[3] = acc[n][3] + bfhi(u.y);
            }
            *(uint2*)(xb + (size_t)row * 1024 + col) = pack4(v);
            ss += v[0] * v[0] + v[1] * v[1] + v[2] * v[2] + v[3] * v[3];
        }
        ss += __shfl_xor(ss, 16); ss += __shfl_xor(ss, 32);
        if ((threadIdx.x & 63) < 16) part[row * 16 + (n0 >> 7) * 2 + ((threadIdx.x >> 6) & 1)] = ss;
    }
};
struct EpiB {
    const float* part; bf16_t* proj;
    DEV void operator()(int row, int col0, const f32x4 (&acc)[4]) const {
        float ss = 0.f;
#pragma unroll
        for (int i = 0; i < 4; ++i) { const f32x4 q = *(const f32x4*)(part + row * 16 + i * 4); ss += q[0] + q[1] + q[2] + q[3]; }
        const float r = rsqrtf(ss * (1.f / 1024.f) + 1e-6f);
#pragma unroll
        for (int n = 0; n < 4; ++n) *(uint2*)(proj + (size_t)row * PROJ_LD + col0 + n * 16) = pack4(acc[n] * r);
    }
};

DEV void attn_item(const Params& p, int layer, int item, unsigned char* smem) {
    const int tid = tidx(), lane = tid & 63, wid = tid >> 6, fr = lane & 15, fq = lane >> 4;
    bf16_t* Ks = (bf16_t*)smem;
    constexpr int VTS = 268;
    bf16_t* Vt = Ks + 256 * 72;
    const bf16_t* proj = (const bf16_t*)(p.ws + WS_PROJ);
    bf16_t* br = (bf16_t*)(p.ws + WS_BR);
    int b, head, qrow0, nq;
    const bool prompt = item < 512;
    if (prompt) { b = item >> 6; head = (item >> 4) & 3; qrow0 = b * 2048 + (item & 15) * 128; nq = 128; }
    else { const int it = item - 512; b = it >> 2; head = it & 3; qrow0 = NTOK_P + b * 8; nq = 8; }
    const int nst = prompt ? 2 : (wid == 0 ? 1 : 0);
    bf16x8 qfp[2][2]; uint2 gtp[2][4];
#pragma unroll
    for (int s2 = 0; s2 < 2; ++s2) {
        if (s2 < nst) {
            const int st = prompt ? wid * 2 + s2 : 0;
            const int ql = st * 16 + fr;
            const int qr = qrow0 + (ql < nq ? ql : 0);
            qfp[s2][0] = ld8(proj + (size_t)qr * PROJ_LD + C_XQ + head * 64 + fq * 8);
            qfp[s2][1] = ld8(proj + (size_t)qr * PROJ_LD + C_XQ + head * 64 + 32 + fq * 8);
#pragma unroll
            for (int dt = 0; dt < 4; ++dt) gtp[s2][dt] = *(const uint2*)(proj + (size_t)qr * PROJ_LD + C_GATE + 768 + head * 64 + dt * 16 + fq * 4);
        }
    }
    __syncthreads();
    if (prompt) {
        const bf16_t* kg = (const bf16_t*)(p.ws + WS_KB) + ((size_t)(layer * 8 + b) * 256) * 256 + head * 64;
        const bf16_t* vg = (const bf16_t*)(p.ws + WS_VB) + ((size_t)(layer * 8 + b) * 256) * 256 + head * 64;
#pragma unroll
        for (int i = 0; i < 8; ++i) {
            const int idx = i * 256 + tid, m = idx >> 3, sg = idx & 7;
            const uint4 kv = *(const uint4*)(kg + (size_t)m * 256 + sg * 8);
            *(uint4*)(Ks + m * 72 + sg * 8) = kv;
            const uint4 vv = *(const uint4*)(vg + (size_t)m * 256 + sg * 8);
            bf16_t* vd = Vt + (sg * 8) * VTS + m;
            vd[0 * VTS] = (bf16_t)(vv.x & 0xffff); vd[1 * VTS] = (bf16_t)(vv.x >> 16);
            vd[2 * VTS] = (bf16_t)(vv.y & 0xffff); vd[3 * VTS] = (bf16_t)(vv.y >> 16);
            vd[4 * VTS] = (bf16_t)(vv.z & 0xffff); vd[5 * VTS] = (bf16_t)(vv.z >> 16);
            vd[6 * VTS] = (bf16_t)(vv.w & 0xffff); vd[7 * VTS] = (bf16_t)(vv.w >> 16);
        }
    } else {
        const float* kg = p.in[I_CK] + ((size_t)(layer * 128 + b) * 256) * 256 + head * 64;
        const float* vg = p.in[I_CV] + ((size_t)(layer * 128 + b) * 256) * 256 + head * 64;
#pragma unroll 8
        for (int i = 0; i < 16; ++i) {
            const int idx = i * 256 + tid, m = idx >> 4, sg = idx & 15;
            const float4 kv = *(const float4*)(kg + (size_t)m * 256 + sg * 4);
            *(uint2*)(Ks + m * 72 + sg * 4) = make_uint2(pack2(kv.x, kv.y), pack2(kv.z, kv.w));
            const float4 vv = *(const float4*)(vg + (size_t)m * 256 + sg * 4);
            bf16_t* vd = Vt + (sg * 4) * VTS + m;
            vd[0] = f2bf(vv.x); vd[VTS] = f2bf(vv.y); vd[2 * VTS] = f2bf(vv.z); vd[3 * VTS] = f2bf(vv.w);
        }
    }
    __syncthreads();
#pragma unroll
    for (int s2 = 0; s2 < 2; ++s2) {
        if (s2 >= nst) break;
        const int st = prompt ? wid * 2 + s2 : 0;
        const int ql = st * 16 + fr;
        const bool valid = ql < nq;
        const int qr = qrow0 + (valid ? ql : 0);
        bf16x8 qf[2];
        qf[0] = qfp[s2][0]; qf[1] = qfp[s2][1];
        f32x4 s[16];
#pragma unroll
        for (int mt = 0; mt < 16; ++mt) {
            s[mt] = (f32x4){0.f, 0.f, 0.f, 0.f};
#pragma unroll
            for (int ks = 0; ks < 2; ++ks) s[mt] = mfma16(ld8(Ks + (mt * 16 + fr) * 72 + ks * 32 + fq * 8), qf[ks], s[mt]);
            if ((mt & 3) == 3) __builtin_amdgcn_sched_barrier(0);
        }
        float mx = -1e30f;
#pragma unroll
        for (int mt = 0; mt < 16; ++mt) mx = fmaxf(fmaxf(fmaxf(s[mt][0], s[mt][1]), fmaxf(s[mt][2], s[mt][3])), mx);
        mx = fmaxf(mx, __shfl_xor(mx, 16)); mx = fmaxf(mx, __shfl_xor(mx, 32));
        float sum = 0.f;
#pragma unroll
        for (int mt = 0; mt < 16; ++mt)
#pragma unroll
            for (int j = 0; j < 4; ++j) { const float e = __expf((s[mt][j] - mx) * 0.125f); s[mt][j] = e; sum += e; }
        sum += __shfl_xor(sum, 16); sum += __shfl_xor(sum, 32);
        f32x4 o[4];
#pragma unroll
        for (int dt = 0; dt < 4; ++dt) o[dt] = (f32x4){0.f, 0.f, 0.f, 0.f};
#pragma unroll
        for (int t = 0; t < 8; ++t) {
            const u32x4 pu = {pack2(s[2 * t][0], s[2 * t][1]), pack2(s[2 * t][2], s[2 * t][3]), pack2(s[2 * t + 1][0], s[2 * t + 1][1]), pack2(s[2 * t + 1][2], s[2 * t + 1][3])};
            const bf16x8 pf = __builtin_bit_cast(bf16x8, pu);
#pragma unroll
            for (int dt = 0; dt < 4; ++dt) {
                const bf16_t* vp = Vt + (dt * 16 + fr) * VTS + (2 * t) * 16 + fq * 4;
                const u32x2 v0 = *(const u32x2*)vp, v1 = *(const u32x2*)(vp + 16);
                const u32x4 vu = {v0[0], v0[1], v1[0], v1[1]};
                o[dt] = mfma16(__builtin_bit_cast(bf16x8, vu), pf, o[dt]);
            }
            __builtin_amdgcn_sched_barrier(0);
        }
        if (valid) {
            const float inv = 1.f / sum;
#pragma unroll
            for (int dt = 0; dt < 4; ++dt) {
                const int col = 768 + head * 64 + dt * 16 + fq * 4;
                const uint2 gt = gtp[s2][dt];
                f32x4 v;
                v[0] = o[dt][0] * inv * silu_f(bflo(gt.x)); v[1] = o[dt][1] * inv * silu_f(bfhi(gt.x));
                v[2] = o[dt][2] * inv * silu_f(bflo(gt.y)); v[3] = o[dt][3] * inv * silu_f(bfhi(gt.y));
                *(uint2*)(br + (size_t)qr * 1024 + col) = pack4(v);
            }
        }
    }
}

template <int CV, int R, int TK>
DEV void gdn_prep(const Params& p, int rowbase, int tseq0, int hist_b, int h,
                  bf16_t* W, bf16_t* UT, bf16_t* QD, bf16_t* KDT, bf16_t* AQK, float* EGL, unsigned char* smem) {
    const int tid = tidx(), lane = tid & 63, wid = tid >> 6, fr = lane & 15, fq = lane >> 4;
    float* As = (float*)smem;
    float* Gs = As + 64 * 64;
    float* Bs = Gs + 64;
    float* Es = Bs + 64;
    bf16_t* qs = (bf16_t*)(Es + 64);
    bf16_t* ks = qs + 64 * 136;
    bf16_t* vs = ks + 64 * 136;
    const bf16_t* proj = (const bf16_t*)(p.ws + WS_PROJ);
    const float* gb = (const float*)(p.ws + WS_G);
    const float* bb = (const float*)(p.ws + WS_BETA);
    const int seqrow0 = rowbase - tseq0;
    __syncthreads();
    float G = (lane < CV) ? gb[(rowbase + lane) * 6 + h] : 0.f;
#pragma unroll
    for (int d = 1; d < 64; d <<= 1) { const float t = __shfl_up(G, d); if (lane >= d) G += t; }
    const float Glast = __shfl(G, 63);
    if (wid == 0) {
        const float be = (lane < CV) ? bb[(rowbase + lane) * 6 + h] : 0.f;
        Gs[lane] = G; Bs[lane] = be; Es[lane] = be * expf(G);
    }
    {
        const int grp = tid & 15, rl = tid >> 4;
        const float* cw = p.in[I_CWA];
        constexpr int RPT = 4;
        if (rl * RPT < R) {
#pragma unroll 1
            for (int sec = 0; sec < 3; ++sec) {
                const int col = sec * 768 + h * 128 + grp * 8;
                f32x4 w0[4], w1[4];
#pragma unroll
                for (int j = 0; j < 4; ++j) { w0[j] = *(const f32x4*)(cw + j * 2304 + col); w1[j] = *(const f32x4*)(cw + j * 2304 + col + 4); }
                bf16_t* dstb = (sec == 0 ? qs : (sec == 1 ? ks : vs)) + grp * 8;
                float xr[RPT + 3][8];
#pragma unroll
                for (int i = 0; i < RPT + 3; ++i) {
                    const int rr = rl * RPT - 3 + i;
                    const int ts = tseq0 + rr;
                    if (rr >= CV) {
#pragma unroll
                        for (int c = 0; c < 8; ++c) xr[i][c] = 0.f;
                    } else if (ts >= 0) {
                        const u32x4 u = *(const u32x4*)(proj + (size_t)(seqrow0 + ts) * PROJ_LD + col);
#pragma unroll
                        for (int c = 0; c < 4; ++c) { xr[i][2 * c] = bflo(u[c]); xr[i][2 * c + 1] = bfhi(u[c]); }
                    } else if (hist_b >= 0) {
                        const f32x4 h0 = *(const f32x4*)(p.in[I_SGC] + (size_t)(hist_b * 3 + 3 + ts) * 2304 + col);
                        const f32x4 h1 = *(const f32x4*)(p.in[I_SGC] + (size_t)(hist_b * 3 + 3 + ts) * 2304 + col + 4);
#pragma unroll
                        for (int c = 0; c < 4; ++c) { xr[i][c] = h0[c]; xr[i][4 + c] = h1[c]; }
                    } else {
#pragma unroll
                        for (int c = 0; c < 8; ++c) xr[i][c] = 0.f;
                    }
                }
#pragma unroll
                for (int i = 0; i < RPT; ++i) {
                    const int r = rl * RPT + i;
                    const bool rv = r < CV;
                    float a[8];
#pragma unroll
                    for (int c = 0; c < 4; ++c) {
                        a[c] = w0[0][c] * xr[i][c] + w0[1][c] * xr[i + 1][c] + w0[2][c] * xr[i + 2][c] + w0[3][c] * xr[i + 3][c];
                        a[4 + c] = w1[0][c] * xr[i][4 + c] + w1[1][c] * xr[i + 1][4 + c] + w1[2][c] * xr[i + 2][4 + c] + w1[3][c] * xr[i + 3][4 + c];
                    }
                    float ss = 0.f;
#pragma unroll
                    for (int c = 0; c < 8; ++c) { a[c] = rv ? silu_f(a[c]) : 0.f; ss += a[c] * a[c]; }
                    float scl = 1.f;
                    if (sec < 2) {
                        ss += __shfl_xor(ss, 1); ss += __shfl_xor(ss, 2); ss += __shfl_xor(ss, 4); ss += __shfl_xor(ss, 8);
                        scl = rsqrtf(ss + 1e-6f) * (sec == 0 ? 0.08838834764831845f : 1.f);
                    }
                    const u32x4 o = {pack2(a[0] * scl, a[1] * scl), pack2(a[2] * scl, a[3] * scl), pack2(a[4] * scl, a[5] * scl), pack2(a[6] * scl, a[7] * scl)};
                    *(u32x4*)(dstb + r * 136) = o;
                    if (sec == 0) {
                        const float s2 = scl * expf(__shfl(G, r));
                        const u32x4 o2 = {pack2(a[0] * s2, a[1] * s2), pack2(a[2] * s2, a[3] * s2), pack2(a[4] * s2, a[5] * s2), pack2(a[6] * s2, a[7] * s2)};
                        *(u32x4*)(QD + r * 128 + grp * 8) = o2;
                    }
                }
            }
        }
    }
    __syncthreads();
    if (wid * 16 < R) {
        const int mt = wid;
        bf16x8 ka[4], qa[4];
#pragma unroll
        for (int k4 = 0; k4 < 4; ++k4) { ka[k4] = ld8(ks + (mt * 16 + fr) * 136 + k4 * 32 + fq * 8); qa[k4] = ld8(qs + (mt * 16 + fr) * 136 + k4 * 32 + fq * 8); }
#pragma unroll
        for (int nt = 0; nt < TK / 16; ++nt) {
            f32x4 akk = (f32x4){0.f, 0.f, 0.f, 0.f}, aqk = (f32x4){0.f, 0.f, 0.f, 0.f};
            if (nt <= mt) {
#pragma unroll
                for (int k4 = 0; k4 < 4; ++k4) { const bf16x8 kb = ld8(ks + (nt * 16 + fr) * 136 + k4 * 32 + fq * 8); akk = mfma16(ka[k4], kb, akk); aqk = mfma16(qa[k4], kb, aqk); }
            }
            const int jc = nt * 16 + fr;
            const float gj = Gs[jc];
#pragma unroll
            for (int j = 0; j < 4; ++j) {
                const int i = mt * 16 + fq * 4 + j;
                const float dec = (jc <= i) ? __expf(Gs[i] - gj) : 0.f;
                As[i * 64 + jc] = (jc < i) ? Bs[i] * akk[j] * dec : 0.f;
                AQK[i * TK + jc] = f2bf(aqk[j] * dec);
            }
        }
    }
    __syncthreads();
    {
        const int c = tid;
        int zero; asm volatile("v_mov_b32 %0, 0" : "=v"(zero));
        const bf16_t* src = ((c < 128) ? ks + c : vs + (c - 128)) + zero;
        const float* sc = ((c < 128) ? Es : Bs) + zero;
        const f32x4* Az = (const f32x4*)As + zero;
        float x[CV];
        constexpr int RB = 8;
#pragma unroll
        for (int ib = 0; ib < CV / RB; ++ib) {
            float a[RB];
#pragma unroll
            for (int r = 0; r < RB; ++r) a[r] = bf2f(src[(ib * RB + r) * 136]) * sc[ib * RB + r];
#pragma unroll
            for (int j4 = 0; j4 < ib * RB / 4; ++j4) {
#pragma unroll
                for (int r = 0; r < RB; ++r) {
                    const f32x4 av = Az[(ib * RB + r) * 16 + j4];
                    a[r] -= av[0] * x[j4 * 4] + av[1] * x[j4 * 4 + 1] + av[2] * x[j4 * 4 + 2] + av[3] * x[j4 * 4 + 3];
                }
            }
            {
                f32x4 d0[RB], d1[RB];
#pragma unroll
                for (int r = 0; r < RB; ++r) { d0[r] = Az[(ib * RB + r) * 16 + ib * 2]; d1[r] = Az[(ib * RB + r) * 16 + ib * 2 + 1]; }
#pragma unroll
                for (int r = 0; r < RB; ++r) {
                    float t = a[r];
#pragma unroll
                    for (int j = 0; j < r; ++j) t -= (j < 4 ? d0[r][j & 3] : d1[r][j & 3]) * x[ib * RB + j];
                    x[ib * RB + r] = t;
                }
            }
            __builtin_amdgcn_sched_barrier(0);
        }
        if (c >= 128) {
            bf16_t* ud = UT + (c - 128) * R;
#pragma unroll
            for (int i8 = 0; i8 < R / 8; ++i8) {
                unsigned wv[4];
#pragma unroll
                for (int k2 = 0; k2 < 4; ++k2) { const int i = i8 * 8 + k2 * 2; wv[k2] = (i < CV) ? pack2(x[i < CV ? i : 0], x[(i + 1) < CV ? (i + 1) : 0]) : 0u; }
                *(uint4*)(ud + i8 * 8) = make_uint4(wv[0], wv[1], wv[2], wv[3]);
            }
        } else {
#pragma unroll
            for (int i = 0; i < R; ++i) qs[i * 136 + c] = (i < CV) ? f2bf(x[i < CV ? i : 0]) : (bf16_t)0;
        }
    }
    __syncthreads();
    for (int idx = tid; idx < R * 16; idx += 256) { const int r = idx >> 4, sg = idx & 15; *(uint4*)(W + r * 128 + sg * 8) = *(const uint4*)(qs + r * 136 + sg * 8); }
    {
        const int cc = tid & 127, half = tid >> 7;
        constexpr int HT = TK / 2;
        unsigned wv[HT / 2];
#pragma unroll
        for (int k2 = 0; k2 < HT / 2; ++k2) {
            const int t = half * HT + 2 * k2;
            const float a = (t < CV) ? bf2f(ks[t * 136 + cc]) * __expf(Glast - Gs[t]) : 0.f;
            const float b = (t + 1 < CV) ? bf2f(ks[(t + 1) * 136 + cc]) * __expf(Glast - Gs[t + 1]) : 0.f;
            wv[k2] = pack2(a, b);
        }
#pragma unroll
        for (int q4 = 0; q4 < HT / 8; ++q4) *(uint4*)(KDT + cc * TK + half * HT + q4 * 8) = make_uint4(wv[q4 * 4], wv[q4 * 4 + 1], wv[q4 * 4 + 2], wv[q4 * 4 + 3]);
    }
    if (tid == 0) *EGL = expf(Glast);
}

template <int MT, int R, int TK>
DEV void gdn_scan(int nchunks, int cstride  , const bf16_t* W0, const bf16_t* UT0, const bf16_t* QD0, const bf16_t* KDT0,
                  const bf16_t* AQK0, const float* EGL0, const float* S0, float* Sout, bf16_t* obase, int nvalid, int s, unsigned char* smem) {
    const int tid = tidx(), lane = tid & 63, wid = tid >> 6, fr = lane & 15, fq = lane >> 4;
    constexpr int VLD = TK + 8;
    bf16_t* ST = (bf16_t*)smem;
    bf16_t* VN = ST + 32 * 136;
    bf16_t* OT = VN + 32 * 72;
    f32x4 Sacc[2][2];
#pragma unroll
    for (int m2 = 0; m2 < 2; ++m2)
#pragma unroll
        for (int nt = 0; nt < 2; ++nt)
#pragma unroll
            for (int j = 0; j < 4; ++j) Sacc[m2][nt][j] = S0 ? S0[((2 * wid + m2) * 16 + fq * 4 + j) * 128 + s * 32 + nt * 16 + fr] : 0.f;
    __syncthreads();
    for (int i = tid; i < 32 * VLD / 2; i += 256) ((unsigned*)VN)[i] = 0u;
#pragma unroll
    for (int m2 = 0; m2 < 2; ++m2)
#pragma unroll
        for (int nt = 0; nt < 2; ++nt) *(uint2*)(ST + (nt * 16 + fr) * 136 + (2 * wid + m2) * 16 + fq * 4) = pack4(Sacc[m2][nt]);
    __syncthreads();
    constexpr int K2 = TK / 32;
    auto ldf = [&](int n, bf16x8 (&kf)[2][K2], bf16x8 (&wf)[4], bf16x8 (&qf)[4], bf16x8 (&af)[K2], u32x2 (&uu)[2], float& egl) {
        const size_t it = (size_t)n * cstride;
        const bf16_t* W = W0 + it * (R * 128); const bf16_t* UT = UT0 + it * (128 * R); const bf16_t* QD = QD0 + it * (R * 128);
        const bf16_t* KDT = KDT0 + it * (128 * TK); const bf16_t* AQK = AQK0 + it * (R * TK);
        egl = EGL0[it];
        if (wid < MT) {
#pragma unroll
            for (int k4 = 0; k4 < 4; ++k4) wf[k4] = ld8(W + (wid * 16 + fr) * 128 + k4 * 32 + fq * 8);
#pragma unroll
            for (int nt = 0; nt < 2; ++nt) uu[nt] = *(const u32x2*)(UT + (s * 32 + nt * 16 + fr) * R + wid * 16 + fq * 4);
        }
#pragma unroll
        for (int m2 = 0; m2 < 2; ++m2)
#pragma unroll
            for (int k2 = 0; k2 < K2; ++k2) kf[m2][k2] = ld8(KDT + ((2 * wid + m2) * 16 + fr) * TK + k2 * 32 + fq * 8);
        if (wid < MT) {
#pragma unroll
            for (int k4 = 0; k4 < 4; ++k4) qf[k4] = ld8(QD + (wid * 16 + fr) * 128 + k4 * 32 + fq * 8);
#pragma unroll
            for (int k2 = 0; k2 < K2; ++k2) af[k2] = ld8(AQK + (wid * 16 + fr) * TK + k2 * 32 + fq * 8);
        }
    };
    auto flush_o = [&](int n) {
        const int t = tid >> 2, sg = tid & 3;
        if (t < nvalid) *(u32x4*)(obase + (size_t)(n * 64 + t) * 768 + sg * 8) = *(const u32x4*)(OT + t * 40 + sg * 8);
    };
    auto comp = [&](int n, const bf16x8 (&kf)[2][K2], const bf16x8 (&wf)[4], const bf16x8 (&qf)[4], const bf16x8 (&af)[K2], const u32x2 (&uu)[2], float egl) {
        f32x4 oacc[2];
        if (wid < MT) {
            bf16x8 sf[2][4];
#pragma unroll
            for (int nt = 0; nt < 2; ++nt)
#pragma unroll
                for (int k4 = 0; k4 < 4; ++k4) sf[nt][k4] = ld8(ST + (nt * 16 + fr) * 136 + k4 * 32 + fq * 8);
#pragma unroll
            for (int nt = 0; nt < 2; ++nt) {
                f32x4 vacc = (f32x4){0.f, 0.f, 0.f, 0.f};
#pragma unroll
                for (int k4 = 0; k4 < 4; ++k4) vacc = mfma16(wf[k4], sf[nt][k4], vacc);
                f32x4 vn;
                vn[0] = bflo(uu[nt][0]) - vacc[0]; vn[1] = bfhi(uu[nt][0]) - vacc[1]; vn[2] = bflo(uu[nt][1]) - vacc[2]; vn[3] = bfhi(uu[nt][1]) - vacc[3];
                *(uint2*)(VN + (nt * 16 + fr) * VLD + wid * 16 + fq * 4) = pack4(vn);
            }
#pragma unroll
            for (int nt = 0; nt < 2; ++nt) {
                oacc[nt] = (f32x4){0.f, 0.f, 0.f, 0.f};
#pragma unroll
                for (int k4 = 0; k4 < 4; ++k4) oacc[nt] = mfma16(qf[k4], sf[nt][k4], oacc[nt]);
            }
        }
        __syncthreads();
        if (n > 0) flush_o(n - 1);
        bf16x8 vf[2][K2];
#pragma unroll
        for (int nt = 0; nt < 2; ++nt)
#pragma unroll
            for (int k2 = 0; k2 < K2; ++k2) vf[nt][k2] = ld8(VN + (nt * 16 + fr) * VLD + k2 * 32 + fq * 8);
#pragma unroll
        for (int m2 = 0; m2 < 2; ++m2)
#pragma unroll
            for (int nt = 0; nt < 2; ++nt) {
                f32x4 a = Sacc[m2][nt] * egl;
#pragma unroll
                for (int k2 = 0; k2 < K2; ++k2) a = mfma16(kf[m2][k2], vf[nt][k2], a);
                Sacc[m2][nt] = a;
                *(uint2*)(ST + (nt * 16 + fr) * 136 + (2 * wid + m2) * 16 + fq * 4) = pack4(a);
            }
        __syncthreads();
        if (wid < MT) {
#pragma unroll
            for (int nt = 0; nt < 2; ++nt) {
#pragma unroll
                for (int k2 = 0; k2 < K2; ++k2) oacc[nt] = mfma16(af[k2], vf[nt][k2], oacc[nt]);
#pragma unroll
                for (int j = 0; j < 4; ++j) OT[(wid * 16 + fq * 4 + j) * 40 + nt * 16 + fr] = f2bf(oacc[nt][j]);
            }
        }
    };
    {
        bf16x8 kfA[2][K2], wfA[4], qfA[4], afA[K2]; u32x2 uuA[2]; float eglA;
        bf16x8 kfB[2][K2], wfB[4], qfB[4], afB[K2]; u32x2 uuB[2]; float eglB;
        ldf(0, kfA, wfA, qfA, afA, uuA, eglA);
        for (int n = 0; n < nchunks; n += 2) {
            ldf(n + 1 < nchunks ? n + 1 : nchunks - 1, kfB, wfB, qfB, afB, uuB, eglB);
            comp(n, kfA, wfA, qfA, afA, uuA, eglA);
            if (n + 1 < nchunks) {
                ldf(n + 2 < nchunks ? n + 2 : nchunks - 1, kfA, wfA, qfA, afA, uuA, eglA);
                comp(n + 1, kfB, wfB, qfB, afB, uuB, eglB);
            }
        }
        __syncthreads();
        flush_o(nchunks - 1);
    }
#pragma unroll
    for (int m2 = 0; m2 < 2; ++m2)
#pragma unroll
        for (int nt = 0; nt < 2; ++nt)
#pragma unroll
            for (int j = 0; j < 4; ++j) Sout[((2 * wid + m2) * 16 + fq * 4 + j) * 128 + s * 32 + nt * 16 + fr] = Sacc[m2][nt][j];
}

DEV void phase_gemm0(const Params& p, unsigned char* smem) {
    EpiA ea{(const float*)(p.ws + WS_RSQ), (bf16_t*)(p.ws + WS_PROJ), (float*)(p.ws + WS_BETA), (float*)(p.ws + WS_G), p.in[I_ALOG], p.in[I_DTB], p.out + O_GCP, p.out + O_GCS};
    EpiA2 ea2{(const float*)(p.ws + WS_RSQ), (bf16_t*)(p.ws + WS_PROJ), p.out + O_GCP, p.out + O_GCS};
    EpiM em{(const float*)(p.ws + WS_RSQM), p.out + O_MK, p.out + O_MV, (bf16_t*)(p.ws + WS_KB), (bf16_t*)(p.ws + WS_VB)};
    for (int t = blockIdx.x; t < 128 + 136 + 136 * 28; t += gridDim.x) {
        if (t < 128) gemm_tile<4>((const bf16_t*)(p.ws + WS_MEMB), (const bf16_t*)(p.ws + WS_WTM), (t >> 3) * 128, (t & 7) * 128, smem, em);
        else if (t < 264) gemm_tile<4>((const bf16_t*)(p.ws + WS_XB), (const bf16_t*)(p.ws + WS_WTA), (t - 128) * 128, 28 * 128, smem, ea);
        else { const int u = t - 264; gemm_tile<4, true>((const bf16_t*)(p.ws + WS_XB), (const bf16_t*)(p.ws + WS_WTA), (u / 28) * 128, (u % 28) * 128, smem, ea2); }
    }
}

DEV void phase_gdnprep_attn(const Params& p, unsigned char* smem, int* sh, int slot = 0) {
    unsigned* cnt = (unsigned*)(p.ws + WS_CNT) + slot;
    unsigned char* yb = (unsigned char*)p.out;
    for (;;) {
        const int slot = next_item(cnt, sh);
        if (slot >= 1536 + 768 + 1024) break;
        int it;
        if (slot < 2048) { const int g = slot >> 2, r = slot & 3; it = (r < 3) ? g * 3 + r : 2304 + 512 + g; }
        else if (slot < 2816) it = 1536 + (slot - 2048);
        else it = 2304 + (slot - 2816);
        if (it < 1536) {
            const int h = it % 6, bn = it / 6, b = bn >> 5, n = bn & 31;
            gdn_prep<64, 64, 64>(p, b * 2048 + n * 64, n * 64, -1, h,
                                 (bf16_t*)(yb + Y_WP) + (size_t)it * 8192, (bf16_t*)(yb + Y_UTP) + (size_t)it * 8192, (bf16_t*)(p.ws + WS_QDP) + (size_t)it * 8192,
                                 (bf16_t*)(p.ws + WS_KDTP) + (size_t)it * 8192, (bf16_t*)(p.ws + WS_AQKP) + (size_t)it * 4096, (float*)(p.ws + WS_EGLP) + it, smem);
        } else if (it < 2304) {
            const int i2 = it - 1536, h = i2 % 6, b = i2 / 6;
            gdn_prep<8, 16, 32>(p, NTOK_P + b * 8, 0, b, h,
                                (bf16_t*)(yb + Y_WS) + (size_t)i2 * 2048, (bf16_t*)(yb + Y_UTS) + (size_t)i2 * 2048, (bf16_t*)(yb + Y_QDS) + (size_t)i2 * 2048,
                                (bf16_t*)(yb + Y_KDTS) + (size_t)i2 * 4096, (bf16_t*)(yb + Y_AQKS) + (size_t)i2 * 512, (float*)(p.ws + WS_EGLS) + i2, smem);
        } else attn_item(p, 0, it - 2304, smem);
    }
}

DEV void scan_prompt_item(const Params& p, int q, int s, unsigned char* smem) {
    unsigned char* yb = (unsigned char*)p.out;
    bf16_t* OB = (bf16_t*)(p.ws + WS_XB);
    const int h = q % 6, b = q / 6;
    const size_t i0 = (size_t)(b * 32) * 6 + h;
    gdn_scan<4, 64, 64>(32, 6, (const bf16_t*)(yb + Y_WP) + i0 * 8192, (const bf16_t*)(yb + Y_UTP) + i0 * 8192, (const bf16_t*)(p.ws + WS_QDP) + i0 * 8192,
                        (const bf16_t*)(p.ws + WS_KDTP) + i0 * 8192, (const bf16_t*)(p.ws + WS_AQKP) + i0 * 4096, (const float*)(p.ws + WS_EGLP) + i0,
                        nullptr, p.out + O_SP + (size_t)(b * 6 + h) * 16384, OB + (size_t)(b * 2048) * 768 + h * 128 + s * 32, 64, s, smem);
}
DEV void late_wtile(const Params& p, int t, unsigned char* smem) {
    bf16_t* WtB = (bf16_t*)(p.ws + WS_WTB); bf16_t* WtO = (bf16_t*)(p.ws + WS_WTO);
    if (t < 896) prep_wtile(p.in[I_WB], 3584, p.in[I_NG] + 1024, WtB, (t >> 4) * 64, (t & 15) * 64, 0, smem);
    else { t -= 896; const int l = t >> 8, tt = t & 255; prep_wtile(p.in[I_WO] + (size_t)l * 1024 * 1024, 1024, nullptr, WtO + (size_t)l * 1024 * 1024, (tt >> 4) * 64, (tt & 15) * 64, 0, smem); }
}
DEV void phase_scan(const Params& p, unsigned char* smem, int* sh, int slot = 1) {
    unsigned* cnt = (unsigned*)(p.ws + WS_CNT) + slot;
    unsigned char* yb = (unsigned char*)p.out;
    bf16_t* OB = (bf16_t*)(p.ws + WS_XB);
    if (gridDim.x >= 192) {
        if (blockIdx.x < 192) { const int x = blockIdx.x & 7, j = blockIdx.x >> 3; scan_prompt_item(p, (j >> 2) * 8 + x, j & 3, smem); }
    } else {
        for (int it = blockIdx.x; it < 192; it += gridDim.x) scan_prompt_item(p, it >> 2, it & 3, smem);
    }
    for (;;) {
        const int i3 = next_item(cnt, sh);
        if (i3 >= 3072 + 1408) break;
        if (i3 >= 3072) { late_wtile(p, i3 - 3072, smem); continue; }
        const int s = i3 & 3, i2 = i3 >> 2, h = i2 % 6, b = i2 / 6;
        gdn_scan<1, 16, 32>(1, 0, (const bf16_t*)(yb + Y_WS) + (size_t)i2 * 2048, (const bf16_t*)(yb + Y_UTS) + (size_t)i2 * 2048, (const bf16_t*)(yb + Y_QDS) + (size_t)i2 * 2048,
                            (const bf16_t*)(yb + Y_KDTS) + (size_t)i2 * 4096, (const bf16_t*)(yb + Y_AQKS) + (size_t)i2 * 512, (const float*)(p.ws + WS_EGLS) + i2,
                            p.in[I_SG] + (size_t)i2 * 16384, p.out + O_SS + (size_t)i2 * 16384, OB + (size_t)(NTOK_P + b * 8) * 768 + h * 128 + s * 32, 8, s, smem);
    }
}

DEV void phase_gate0(const Params& p) {
    const int tid_ = tidx(); const int lane = tid_ & 63, wid = tid_ >> 6;
    const bf16_t* OB = (const bf16_t*)(p.ws + WS_XB);
    const bf16_t* proj = (const bf16_t*)(p.ws + WS_PROJ);
    bf16_t* br = (bf16_t*)(p.ws + WS_BR);
    const float2 g = *(const float2*)(p.in[I_ONG] + 2 * lane);
    for (int row = blockIdx.x * 4 + wid; row < NTOK; row += gridDim.x * 4) {
        unsigned uo[6], ug[6];
#pragma unroll
        for (int h = 0; h < 6; ++h) {
            uo[h] = *(const unsigned*)(OB + (size_t)row * 768 + h * 128 + 2 * lane);
            ug[h] = *(const unsigned*)(proj + (size_t)row * PROJ_LD + C_GATE + h * 128 + 2 * lane);
        }
        unsigned res[6];
#pragma unroll
        for (int h = 0; h < 6; ++h) {
            const float a = bflo(uo[h]), b = bfhi(uo[h]);
            const float ss = wave_sum(a * a + b * b);
            const float r = rsqrtf(ss * (1.f / 128.f) + 1e-6f);
            res[h] = pack2(a * r * g.x * silu_f(bflo(ug[h])), b * r * g.y * silu_f(bfhi(ug[h])));
        }
#pragma unroll
        for (int h = 0; h < 6; ++h) *(unsigned*)(br + (size_t)row * 1024 + h * 128 + 2 * lane) = res[h];
    }
}

DEV void phase_gemm_out(const Params& p, int layer, unsigned char* smem) {
    const bf16_t* A = (const bf16_t*)(p.ws + WS_BR); const bf16_t* Bt = (const bf16_t*)(p.ws + WS_WTO) + (size_t)layer * 1024 * 1024;
    const int G = gridDim.x, NTILES = 136 * 8, full = (NTILES / G) * G, rem = NTILES - full;
    auto mk = [&](int n0) { return EpiO{layer == 0 ? p.in[I_XP] : nullptr, layer == 0 ? p.in[I_XS] : nullptr, (bf16_t*)(p.ws + WS_XB), (float*)(p.ws + WS_PART), n0}; };
    for (int t = blockIdx.x; t < full; t += G) { const int n0 = (t & 7) * 128; gemm_tile<4>(A, Bt, (t >> 3) * 128, n0, smem, mk(n0)); }
    if (rem * 4 <= G) {
        for (int hh = blockIdx.x; hh < rem * 4; hh += G) { const int t = full + (hh >> 2), n0 = (t & 7) * 128; gemm_tile<1>(A, Bt, (t >> 3) * 128 + (hh & 3) * 32, n0, smem, mk(n0)); }
    } else if (rem * 2 <= G) {
        for (int hh = blockIdx.x; hh < rem * 2; hh += G) { const int t = full + (hh >> 1), n0 = (t & 7) * 128; gemm_tile<2>(A, Bt, (t >> 3) * 128 + (hh & 1) * 64, n0, smem, mk(n0)); }
    } else {
        for (int t = full + blockIdx.x; t < NTILES; t += G) { const int n0 = (t & 7) * 128; gemm_tile<4>(A, Bt, (t >> 3) * 128, n0, smem, mk(n0)); }
    }
}

DEV void phase_gemm1(const Params& p, unsigned char* smem) {
    EpiB2 eb{(const float*)(p.ws + WS_PART), (bf16_t*)(p.ws + WS_PROJ)};
    const bf16_t* A = (const bf16_t*)(p.ws + WS_XB); const bf16_t* Bt = (const bf16_t*)(p.ws + WS_WTB);
    const int G = gridDim.x, NTILES = 136 * 28, full = (NTILES / G) * G, rem = NTILES - full;
    for (int t = blockIdx.x; t < full; t += G) gemm_tile<4, true>(A, Bt, (t / 28) * 128, (t % 28) * 128, smem, eb);
    if (rem * 2 <= G) {
        for (int hh = blockIdx.x; hh < rem * 2; hh += G) { const int t = full + (hh >> 1); gemm_tile<2, true>(A, Bt, (t / 28) * 128 + (hh & 1) * 64, (t % 28) * 128, smem, eb); }
    } else {
        for (int t = full + blockIdx.x; t < NTILES; t += G) gemm_tile<4, true>(A, Bt, (t / 28) * 128, (t % 28) * 128, smem, eb);
    }
}

DEV void sconv_rows(const Params& p, int blk) {
    const int tid_ = tidx(); const int lane = tid_ & 63, wid = tid_ >> 6;
    const int row = blk * 4 + wid;
    const bf16_t* proj = (const bf16_t*)(p.ws + WS_PROJ);
    bf16_t* br = (bf16_t*)(p.ws + WS_BR);
    const float* cw = p.in[I_CWB];
    int t, L, b; size_t seqrow0;
    if (row < NTOK_P) { b = row >> 11; t = row & 2047; L = 2048; seqrow0 = (size_t)b * 2048; }
    else { const int rs = row - NTOK_P; b = rs >> 3; t = rs & 7; L = 8; seqrow0 = NTOK_P + (size_t)b * 8; }
    f32x4 ov[3], ul[3];
#pragma unroll
    for (int i = 0; i < 3; ++i) {
        const int c = i * 256 + lane * 4;
        f32x4 u[3];
#pragma unroll
        for (int j = 0; j < 3; ++j) {
            const int ts = t - 2 + j;
            if (ts >= 0) {
                const bf16_t* pr = proj + (seqrow0 + ts) * PROJ_LD;
                const uint2 cg = *(const uint2*)(pr + 768 + c), xs = *(const uint2*)(pr + 1536 + c);
                u[j][0] = bflo(cg.x) * bflo(xs.x); u[j][1] = bfhi(cg.x) * bfhi(xs.x); u[j][2] = bflo(cg.y) * bflo(xs.y); u[j][3] = bfhi(cg.y) * bfhi(xs.y);
            } else if (row >= NTOK_P) u[j] = *(const f32x4*)(p.in[I_SSC] + (size_t)(b * 2 + 2 + ts) * 768 + c);
            else u[j] = (f32x4){0.f, 0.f, 0.f, 0.f};
        }
        const f32x4 w0 = *(const f32x4*)(cw + c), w1 = *(const f32x4*)(cw + 768 + c), w2 = *(const f32x4*)(cw + 1536 + c);
        const f32x4 y = w0 * u[0] + w1 * u[1] + w2 * u[2];
        const bf16_t* pr = proj + (size_t)row * PROJ_LD;
        const uint2 bg = *(const uint2*)(pr + c), gt = *(const uint2*)(pr + C_GATE + c);
        ov[i][0] = bflo(bg.x) * y[0] * silu_f(bflo(gt.x)); ov[i][1] = bfhi(bg.x) * y[1] * silu_f(bfhi(gt.x));
        ov[i][2] = bflo(bg.y) * y[2] * silu_f(bflo(gt.y)); ov[i][3] = bfhi(bg.y) * y[3] * silu_f(bfhi(gt.y));
        ul[i] = u[2];
    }
#pragma unroll
    for (int i = 0; i < 3; ++i) {
        const int c = i * 256 + lane * 4;
        *(uint2*)(br + (size_t)row * 1024 + c) = pack4(ov[i]);
        if (t >= L - 2) {
            float* dst = (row < NTOK_P ? p.out + O_SCP : p.out + O_SCS) + (size_t)(b * 2 + (t - (L - 2))) * 768 + c;
            *(f32x4*)dst = ul[i];
        }
    }
}
DEV void phase_sconv_attn(const Params& p, unsigned char* smem, int* sh, int slot = 2) {
    unsigned* cnt = (unsigned*)(p.ws + WS_CNT) + slot;
    for (;;) {
        const int it = next_item(cnt, sh);
        if (it >= 1024 + NTOK / 4) break;
        if (it < 1024) attn_item(p, 1, (it & 1) * 512 + (it >> 1), smem);
        else sconv_rows(p, it - 1024);
    }
}

DEV void phase_final(const Params& p) {
    const int tid_ = tidx(); const int lane = tid_ & 63, wid = tid_ >> 6;
    const float* part = (const float*)(p.ws + WS_PART);
    const bf16_t* xb = (const bf16_t*)(p.ws + WS_XB);
    const float* g = p.in[I_FNG];
    float* y = p.out + O_Y;
    for (int row = blockIdx.x * 4 + wid; row < NTOK; row += gridDim.x * 4) {
        float ss = (lane < 16) ? part[row * 16 + lane] : 0.f;
        ss = wave_sum(ss);
        const float r = rsqrtf(ss * (1.f / 1024.f) + 1e-6f);
#pragma unroll
        for (int i = 0; i < 4; ++i) {
            const uint2 u = ((const uint2*)(xb + (size_t)row * 1024))[i * 64 + lane];
            const f32x4 gg = ((const f32x4*)g)[i * 64 + lane];
            f32x4 v = {bflo(u.x), bfhi(u.x), bflo(u.y), bfhi(u.y)};
            ((f32x4*)(y + (size_t)row * 1024))[i * 64 + lane] = v * r * gg;
        }
    }
}

DEV void run_phase(const Params& p, int ph, unsigned char* smem, int* sh) {
    switch (ph) {
    case 0: phase_prep(p, smem); break;
    case 1: phase_gemm0(p, smem); break;
    case 2: phase_gdnprep_attn(p, smem, sh); break;
    case 3: phase_scan(p, smem, sh); break;
    case 4: phase_gate0(p); break;
    case 5: phase_gemm_out(p, 0, smem); break;
    case 6: phase_gemm1(p, smem); break;
    case 7: phase_sconv_attn(p, smem, sh); break;
    case 8: phase_gemm_out(p, 1, smem); break;
    default: phase_final(p); break;
    }
}

extern __shared__ __attribute__((aligned(16))) unsigned char dyn_smem[];

#if !defined(ONLY) && !MULTI
__global__ void __launch_bounds__(256, 2) k_mega(Params p) {
    __shared__ int sh_item[4];
    cg::grid_group grid = cg::this_grid();
    __shared__ uint4 xb_words;
    if (threadIdx.x == 0) xb_words = make_uint4(0u, 0u, 0u, 0u);
    __syncthreads();
    XcdBarrier xb = xcd_barrier_post((unsigned*)(p.ws + WS_XBAR), (volatile LAS unsigned*)&xb_words);
    if (p.ws == nullptr) grid.sync();
    phase_prep(p, dyn_smem); xcd_barrier(xb);
    phase_gemm0(p, dyn_smem); xcd_barrier(xb);
    phase_gdnprep_attn(p, dyn_smem, sh_item); xcd_barrier(xb);
    phase_scan(p, dyn_smem, sh_item); xcd_barrier(xb);
    phase_gate0(p); xcd_barrier(xb);
    phase_gemm_out(p, 0, dyn_smem); xcd_barrier(xb);
    phase_gemm1(p, dyn_smem); xcd_barrier(xb);
    phase_sconv_attn(p, dyn_smem, sh_item); xcd_barrier(xb);
    phase_gemm_out(p, 1, dyn_smem); xcd_barrier(xb);
    phase_final(p);
}

#endif
__global__ void __launch_bounds__(256, 2) k_phase(Params p, int ph) {
    __shared__ int sh_item[4];
#ifdef ONLY
    run_phase(p, ONLY, dyn_smem, sh_item);
#else
    run_phase(p, ph, dyn_smem, sh_item);
#endif
}

extern "C" void kernel_launch(void* const* d_in, const int* in_sizes, int n_in, void* d_out, int out_size, void* d_ws, size_t ws_size, hipStream_t stream) {
    static int grid_blocks = 0;
    if (!grid_blocks) {
        if (n_in != 20 || ws_size < WS_END) { fprintf(stderr, "kernel_launch: unexpected n_in %d / ws_size %zu (need %zu)\n", n_in, ws_size, (size_t)WS_END); grid_blocks = -1; return; }
        int dev = 0, cus = 0, per_cu = 0;
        (void)hipGetDevice(&dev);
        (void)hipDeviceGetAttribute(&cus, hipDeviceAttributeMultiprocessorCount, dev);
#if MULTI
        (void)hipFuncSetAttribute((const void*)k_phase, hipFuncAttributeMaxDynamicSharedMemorySize, LDS_BYTES);
        (void)hipOccupancyMaxActiveBlocksPerMultiprocessor(&per_cu, (const void*)k_phase, 256, LDS_BYTES);
#else
        (void)hipFuncSetAttribute((const void*)k_mega, hipFuncAttributeMaxDynamicSharedMemorySize, LDS_BYTES);
        (void)hipOccupancyMaxActiveBlocksPerMultiprocessor(&per_cu, (const void*)k_mega, 256, LDS_BYTES);
#endif
        if (per_cu < 1) per_cu = 1;
        if (per_cu > 2) per_cu = 2;
        grid_blocks = cus * per_cu;
        (void)hipGetLastError();
    }
    if (grid_blocks < 0) return;
    Params p{};
    for (int i = 0; i < 20; ++i) p.in[i] = (const float*)d_in[i];
    p.out = (float*)d_out; p.ws = (unsigned char*)d_ws;
#ifdef CLEARALL
    (void)hipMemsetAsync(d_ws, 0, WS_END, stream);
    (void)hipMemsetAsync(d_out, 0, (size_t)out_size * 4, stream);
#endif
#if MULTI
    for (int ph = 0; ph < RUNPH; ++ph) hipLaunchKernelGGL(k_phase, dim3(grid_blocks), dim3(256), LDS_BYTES, stream, p, ph);
#ifdef CLEARALL
    if (RUNPH < 6) (void)hipMemsetAsync(d_out, 0, 17825792ull * 4, stream);
#endif
#else
    (void)hipMemsetAsync((unsigned char*)d_ws + WS_XBAR, 0, XCD_BAR_WORDS * 4, stream);
    void* args[] = {&p};
    hipError_t e = hipLaunchCooperativeKernel((const void*)k_mega, dim3(grid_blocks), dim3(256), args, LDS_BYTES, stream);
    if (e != hipSuccess) fprintf(stderr, "cooperative launch failed: %s (grid %d)\n", hipGetErrorString(e), grid_blocks);
#endif
}
```
